# Optimizing an MI355X kernel written in HIP

```python
import jax, jax.numpy as jnp
from jax import lax
import numpy as np

D_MODEL = 1024
BATCH = 8
SEQ = 2048
DEPTH = 1

SB_HEADS = 8
SB_HEAD_DIM = 64
SB_WIDTH = SB_HEADS * SB_HEAD_DIM
MLA_HEADS = 4
MLA_NOPE_DIM = 128
MLA_ROPE_DIM = 64
MLA_QK_DIM = MLA_NOPE_DIM + MLA_ROPE_DIM
MLA_V_DIM = 128
MLA_Q_RANK = 384
MLA_KV_RANK = 256
MLA_WIDTH = MLA_HEADS * MLA_V_DIM
MIX_WIDTH = SB_WIDTH + MLA_WIDTH
IN_PROJ_WIDTH = 3 * SB_WIDTH + MLA_Q_RANK + MLA_KV_RANK + MLA_ROPE_DIM
D_FF = -(-8 * D_MODEL // (3 * 256)) * 256
N_MOD = 6
BLOCK_Q = 128
ROPE_THETA = 10000.0
EPS = 1e-6

kernel_name = "hymba_sb_mla_adaln_layer"


def rms_norm(x, g):
    xf = x.astype(jnp.float32)
    y = xf * lax.rsqrt(jnp.mean(xf * xf, axis=-1, keepdims=True) + EPS)
    return (y * g.astype(jnp.float32)).astype(x.dtype)


def apply_rope(x, positions):
    half = x.shape[-1] // 2
    freqs = 1.0 / (ROPE_THETA ** (jnp.arange(half, dtype=jnp.float32) / half))
    ang = positions.astype(jnp.float32)[:, :, None, None] * freqs
    cos, sin = jnp.cos(ang), jnp.sin(ang)
    xf = x.astype(jnp.float32)
    x1, x2 = xf[..., :half], xf[..., half:]
    return jnp.concatenate([x1 * cos - x2 * sin, x2 * cos + x1 * sin], axis=-1).astype(x.dtype)


def stick_breaking_attention(q, k, v):
    S = q.shape[1]
    scale = SB_HEAD_DIM ** -0.5
    outs = []
    for i in range(S // BLOCK_Q):
        q0 = i * BLOCK_Q
        kend = q0 + BLOCK_Q
        z = jnp.einsum('bthd,bshd->bhts', q[:, q0:kend], k[:, :kend]).astype(jnp.float32) * scale
        t_idx = q0 + jnp.arange(BLOCK_Q)[:, None]
        s_idx = jnp.arange(kend)[None, :]
        strict = s_idx < t_idx
        log_beta = jax.nn.log_sigmoid(z)
        log_1m = jnp.where(strict, jax.nn.log_sigmoid(-z), 0.0)
        after = lax.cumsum(log_1m, axis=3, reverse=True) - log_1m
        w = jnp.where(strict, jnp.exp(log_beta + after), 0.0)
        outs.append(jnp.einsum('bhts,bshd->bthd', w.astype(v.dtype), v[:, :kend]))
    return jnp.concatenate(outs, axis=1)


def causal_softmax_attention(q, k, v):
    S = q.shape[1]
    scale = MLA_QK_DIM ** -0.5
    outs = []
    for i in range(S // BLOCK_Q):
        q0 = i * BLOCK_Q
        kend = q0 + BLOCK_Q
        s = jnp.einsum('bthd,bshd->bhts', q[:, q0:kend], k[:, :kend]).astype(jnp.float32) * scale
        causal = jnp.arange(kend)[None, :] <= (q0 + jnp.arange(BLOCK_Q))[:, None]
        p = jax.nn.softmax(jnp.where(causal, s, -jnp.inf), axis=-1)
        outs.append(jnp.einsum('bhts,bshd->bthd', p.astype(v.dtype), v[:, :kend]))
    return jnp.concatenate(outs, axis=1)


def setup_inputs(seed: int = 0) -> dict:
    key = jax.random.key(seed)
    ks = jax.random.split(key, 24)
    f32 = jnp.float32

    def w(k, shape, fan_in):
        return jax.random.normal(k, shape, f32) * (fan_in ** -0.5)

    def gain(k, n):
        return 1.0 + 0.01 * jax.random.normal(k, (DEPTH, n), f32)

    x = jax.random.normal(ks[0], (BATCH, SEQ, D_MODEL), f32)
    c = jax.random.normal(ks[1], (BATCH, D_MODEL), f32)
    offsets = jax.random.randint(ks[2], (BATCH, 1), 0, 512, dtype=jnp.int32)
    positions = offsets + jnp.arange(SEQ, dtype=jnp.int32)[None, :]
    return {
        "x": x,
        "c": c,
        "positions": positions,
        "w_ada": w(ks[3], (DEPTH, D_MODEL, N_MOD * D_MODEL), D_MODEL) * 0.5,
        "b_ada": 0.01 * jax.random.normal(ks[4], (DEPTH, N_MOD * D_MODEL), f32),
        "norm_attn": gain(ks[5], D_MODEL),
        "norm_ffn": gain(ks[6], D_MODEL),
        "w_in": w(ks[7], (DEPTH, D_MODEL, IN_PROJ_WIDTH), D_MODEL),
        "q_a_norm": gain(ks[8], MLA_Q_RANK),
        "w_q_up": w(ks[9], (DEPTH, MLA_Q_RANK, MLA_HEADS * MLA_QK_DIM), MLA_Q_RANK),
        "kv_a_norm": gain(ks[10], MLA_KV_RANK),
        "w_kv_up": w(ks[11], (DEPTH, MLA_KV_RANK, MLA_HEADS * (MLA_NOPE_DIM + MLA_V_DIM)), MLA_KV_RANK),
        "q_norm": gain(ks[12], MLA_QK_DIM),
        "k_nope_norm": gain(ks[13], MLA_NOPE_DIM),
        "k_rope_norm": gain(ks[14], MLA_ROPE_DIM),
        "out_norm_sb": gain(ks[15], SB_WIDTH),
        "out_norm_mla": gain(ks[16], MLA_WIDTH),
        "w_out": w(ks[17], (DEPTH, MIX_WIDTH, D_MODEL), MIX_WIDTH),
        "w_gate": w(ks[18], (DEPTH, D_MODEL, D_FF), D_MODEL),
        "w_up": w(ks[19], (DEPTH, D_MODEL, D_FF), D_MODEL),
        "w_down": w(ks[20], (DEPTH, D_FF, D_MODEL), D_FF),
    }


def reference(x, c, positions, w_ada, b_ada, norm_attn, norm_ffn, w_in, q_a_norm, w_q_up,
              kv_a_norm, w_kv_up, q_norm, k_nope_norm, k_rope_norm, out_norm_sb, out_norm_mla,
              w_out, w_gate, w_up, w_down):
    B, S, _ = x.shape
    for l in range(DEPTH):
        mod = jax.nn.silu(c) @ w_ada[l] + b_ada[l]
        shift1, scale1, gate1, shift2, scale2, gate2 = [m[:, None, :] for m in jnp.split(mod, N_MOD, axis=-1)]

        h = rms_norm(x, norm_attn[l]) * (1.0 + scale1) + shift1
        proj = h @ w_in[l]
        cuts = np.cumsum([SB_WIDTH, SB_WIDTH, SB_WIDTH, MLA_Q_RANK, MLA_KV_RANK]).tolist()
        q_sb, k_sb, v_sb, c_q, c_kv, k_rope = jnp.split(proj, cuts, axis=-1)

        q_sb = q_sb.reshape(B, S, SB_HEADS, SB_HEAD_DIM)
        k_sb = k_sb.reshape(B, S, SB_HEADS, SB_HEAD_DIM)
        v_sb = v_sb.reshape(B, S, SB_HEADS, SB_HEAD_DIM)
        o_sb = stick_breaking_attention(q_sb, k_sb, v_sb).reshape(B, S, SB_WIDTH)

        q = (rms_norm(c_q, q_a_norm[l]) @ w_q_up[l]).reshape(B, S, MLA_HEADS, MLA_QK_DIM)
        kv = (rms_norm(c_kv, kv_a_norm[l]) @ w_kv_up[l]).reshape(B, S, MLA_HEADS, MLA_NOPE_DIM + MLA_V_DIM)
        k_nope, v_mla = kv[..., :MLA_NOPE_DIM], kv[..., MLA_NOPE_DIM:]
        q = rms_norm(q, q_norm[l])
        k_nope = rms_norm(k_nope, k_nope_norm[l])
        k_rope = rms_norm(k_rope, k_rope_norm[l])[:, :, None, :]
        q = jnp.concatenate([q[..., :MLA_NOPE_DIM], apply_rope(q[..., MLA_NOPE_DIM:], positions)], axis=-1)
        k_rope = jnp.broadcast_to(apply_rope(k_rope, positions), (B, S, MLA_HEADS, MLA_ROPE_DIM))
        k = jnp.concatenate([k_nope, k_rope], axis=-1)
        o_mla = causal_softmax_attention(q, k, v_mla).reshape(B, S, MLA_WIDTH)

        mixed = jnp.concatenate([rms_norm(o_sb, out_norm_sb[l]), rms_norm(o_mla, out_norm_mla[l])], axis=-1)
        x = x + gate1 * (mixed @ w_out[l])

        h = rms_norm(x, norm_ffn[l]) * (1.0 + scale2) + shift2
        ffn = (jax.nn.silu(h @ w_gate[l]) * (h @ w_up[l])) @ w_down[l]
        x = x + gate2 * ffn
    return x
```

```cpp
#include <hip/hip_runtime.h>
#include <hip/hip_cooperative_groups.h>
#include <cstdio>
#include <cstdint>
namespace cg = cooperative_groups;

#define LAS __attribute__((address_space(3)))
typedef unsigned short bf16_t;
typedef unsigned v4u __attribute__((ext_vector_type(4)));
typedef float f32x4 __attribute__((ext_vector_type(4)));

constexpr int BATCH = 8, SEQ = 2048, D = 1024, M = BATCH * SEQ;
constexpr int SBH = 8, SBD = 64, SBW = 512;
constexpr int MH = 4, MNOPE = 128, MROPE = 64, MQK = 192, MV = 128, QRANK = 384, KVRANK = 256;
constexpr int NPROJ_REAL = 2240, NPROJ = 2304;
constexpr int C_CQ = 1536, C_CKV = 1920, C_KR = 2176;
constexpr int FF = 2816;
constexpr float EPS = 1e-6f;
constexpr int NW = 8, NT = NW * 64;

constexpr size_t MiB = 1u << 20;
constexpr size_t WS_MOD = 0, WS_WIN = 1 * MiB, WS_WQ = 6 * MiB, WS_WKV = 7 * MiB, WS_WOUT = 8 * MiB, WS_WGU = 10 * MiB, WS_WD = 21 * MiB;
constexpr size_t WS_SS = 27 * MiB, WS_H = 28 * MiB, WS_PROJ = 60 * MiB, WS_QM = 132 * MiB, WS_KM = 156 * MiB, WS_VM = 180 * MiB, WS_O = 196 * MiB;
constexpr size_t WS_A2 = 60 * MiB, WS_COS = 228 * MiB, WS_SIN = 230 * MiB, WS_END = 232 * MiB;
constexpr int LDS_BYTES = 147456, MISC_OFF = 135168;
constexpr size_t WS_CTL = 256 * 1024, WS_QC = WS_CTL + 16 * 1024, WS_PCNT = WS_CTL + 24 * 1024, CTL_ZERO_BYTES = 40 * 1024, WS_XBUF = 512 * 1024;

__device__ __forceinline__ float bf2f(unsigned v) { return __uint_as_float(v << 16); }
__device__ __forceinline__ unsigned f2bf(float f) { unsigned u = __float_as_uint(f); return (u + 0x7fffu + ((u >> 16) & 1u)) >> 16; }
__device__ __forceinline__ unsigned pk2(float lo, float hi) { return f2bf(lo) | (f2bf(hi) << 16); }
__device__ __forceinline__ float wave_sum(float v) {
#pragma unroll
    for (int o = 1; o < 64; o <<= 1) v += __shfl_xor(v, o);
    return v;
}
__device__ __forceinline__ float wave_max(float v) {
#pragma unroll
    for (int o = 1; o < 64; o <<= 1) v = fmaxf(v, __shfl_xor(v, o));
    return v;
}
__device__ __forceinline__ float siluf(float v) { return v / (1.f + expf(-v)); }
__device__ __forceinline__ float logsig(float z) { return fminf(z, 0.f) - log1pf(expf(-fabsf(z))); }
__device__ __forceinline__ float dot8(v4u a, v4u b) {
    float s = 0.f;
    s += bf2f(a.x & 0xffffu) * bf2f(b.x & 0xffffu); s += __uint_as_float(a.x & 0xffff0000u) * __uint_as_float(b.x & 0xffff0000u);
    s += bf2f(a.y & 0xffffu) * bf2f(b.y & 0xffffu); s += __uint_as_float(a.y & 0xffff0000u) * __uint_as_float(b.y & 0xffff0000u);
    s += bf2f(a.z & 0xffffu) * bf2f(b.z & 0xffffu); s += __uint_as_float(a.z & 0xffff0000u) * __uint_as_float(b.z & 0xffff0000u);
    s += bf2f(a.w & 0xffffu) * bf2f(b.w & 0xffffu); s += __uint_as_float(a.w & 0xffff0000u) * __uint_as_float(b.w & 0xffff0000u);
    return s;
}


__device__ __forceinline__ int tid_now() { int t = threadIdx.x; asm volatile("" : "+v"(t)); return t; }
__device__ __forceinline__ int lane_now() { return tid_now() & 63; }

namespace pg8 {
#define PG8_LAS __attribute__((address_space(3)))
typedef short bf16x8 __attribute__((ext_vector_type(8)));
typedef unsigned u32x4 __attribute__((ext_vector_type(4)));
typedef float f32x2 __attribute__((ext_vector_type(2)));
constexpr int BM = 256, BK = 64, HALF = 128, HTB = HALF * BK * 2, STAGE_BYTES = 8 * HTB, NXCD = 8, WGM = 8;
__host__ __device__ __forceinline__ int lds_byte(int r, int c) { const int st = (r >> 4) * 2 + (c >> 5), rr = r & 15, cc = c & 31, ob = rr * 64 + cc * 2; return st * 1024 + (ob ^ (((ob >> 9) & 1) << 5)); }
__host__ __device__ __forceinline__ void stage_rc(int b, int& R, int& C) { const int st = b / 1024, sb = b % 1024, swz = sb ^ (((sb >> 9) & 1) << 5); R = (st >> 1) * 16 + swz / 64; C = (st & 1) * 32 + (swz % 64) / 2; }
__host__ __device__ __forceinline__ int perm32(int rho) { const int n = rho >> 4, i = rho & 15; return 8 * (i >> 2) + 4 * n + (i & 3); }
struct Unit { int pm, pn; };
struct Gemm { const bf16_t* A; const bf16_t* Bt; int M, N, K, lda; };
struct StaticOrder {
    int nM, nN, nwg, G, c;
    __host__ __device__ void init(int M_, int N_, int G_, int c_) { nM = M_ / BM; nN = N_ / BM; nwg = nM * nN; G = G_; c = c_; }
    __host__ __device__ bool next(int i, Unit& u) const {
        const long L = (long)i * G + c; if (L >= nwg) return false;
        int wgid = (int)L; { const int q = nwg / NXCD, r = nwg % NXCD, xcd = wgid % NXCD, off = wgid / NXCD; wgid = (xcd < r ? xcd * (q + 1) : r * (q + 1) + (xcd - r) * q) + off; }
        const int nig = WGM * nN, gid = wgid / nig, fm = gid * WGM, gsz = (nM - fm) < WGM ? (nM - fm) : WGM;
        u.pm = fm + ((wgid % nig) % gsz); u.pn = (wgid % nig) / gsz; return true;
    }
};
__device__ __forceinline__ unsigned cvt_pk_bf16(float lo, float hi) { unsigned r; asm volatile("v_cvt_pk_bf16_f32 %0, %1, %2" : "=v"(r) : "v"(lo), "v"(hi)); return r; }
struct EpiBf16 {
    static constexpr bool PERM = true, AFTER_DRAIN = false;
    __device__ __forceinline__ void khook(f32x4 (&)[2][2][4][2], const Unit&, int, int, int) const {}
    bf16_t* O; int ldc;
    __device__ __forceinline__ void operator()(const f32x4 (&acc)[2][2][4][2], const Unit& u, int wr, int wc, int fr, int fq) const {
        const int row0 = u.pm * BM + wr * 64 + fr, col0 = u.pn * BM + wc * 32 + 8 * fq;
#pragma unroll
        for (int ai = 0; ai < 2; ++ai)
#pragma unroll
            for (int m = 0; m < 4; ++m) { bf16_t* rowp = O + (size_t)(row0 + ai * HALF + m * 16) * ldc + col0;
#pragma unroll
                for (int bj = 0; bj < 2; ++bj) { const f32x4 v0 = acc[ai][bj][m][0], v1 = acc[ai][bj][m][1];
                    u32x4 w; w.x = cvt_pk_bf16(v0[0], v0[1]); w.y = cvt_pk_bf16(v0[2], v0[3]); w.z = cvt_pk_bf16(v1[0], v1[1]); w.w = cvt_pk_bf16(v1[2], v1[3]);
                    *(u32x4*)(rowp + bj * HALF) = w; } }
    }
};
__device__ __forceinline__ float silu_fast(float g) { return g * __builtin_amdgcn_rcpf(1.f + __builtin_amdgcn_exp2f(-1.4426950408889634f * g)); }
struct EpiSwiglu {
    static constexpr bool PERM = true, AFTER_DRAIN = false;
    __device__ __forceinline__ void khook(f32x4 (&)[2][2][4][2], const Unit&, int, int, int) const {}
    bf16_t* O; int ldc;
    __device__ __forceinline__ void operator()(const f32x4 (&acc)[2][2][4][2], const Unit& u, int wr, int wc, int fr, int fq) const {
        const int row0 = u.pm * BM + wr * 64 + fr, col0 = u.pn * HALF + wc * 32 + 8 * fq;
#pragma unroll
        for (int ai = 0; ai < 2; ++ai)
#pragma unroll
            for (int m = 0; m < 4; ++m) { bf16_t* rowp = O + (size_t)(row0 + ai * HALF + m * 16) * ldc + col0;
                const f32x4 g0 = acc[ai][0][m][0], g1 = acc[ai][0][m][1], u0 = acc[ai][1][m][0], u1 = acc[ai][1][m][1];
                u32x4 w;
                w.x = cvt_pk_bf16(silu_fast(g0[0]) * u0[0], silu_fast(g0[1]) * u0[1]); w.y = cvt_pk_bf16(silu_fast(g0[2]) * u0[2], silu_fast(g0[3]) * u0[3]);
                w.z = cvt_pk_bf16(silu_fast(g1[0]) * u1[0], silu_fast(g1[1]) * u1[1]); w.w = cvt_pk_bf16(silu_fast(g1[2]) * u1[2], silu_fast(g1[3]) * u1[3]);
                *(u32x4*)rowp = w; }
    }
};
struct EpiRes {
    static constexpr bool PERM = false, AFTER_DRAIN = false;
    __device__ __forceinline__ void khook(f32x4 (&)[2][2][4][2], const Unit&, int, int, int) const {}
    const float* base; float* out; const float* gate;
    __device__ __forceinline__ void operator()(const f32x4 (&acc)[2][2][4][2], const Unit& u, int wr, int wc, int fr, int fq) const {
        const int b = (u.pm * BM) / SEQ, col0 = u.pn * BM + wc * 32 + 4 * fq;
        f32x4 gv[2][2];
#pragma unroll
        for (int bj = 0; bj < 2; ++bj)
#pragma unroll
            for (int n = 0; n < 2; ++n) gv[bj][n] = *(const f32x4*)(gate + (size_t)b * 6144 + col0 + bj * HALF + n * 16);
#pragma unroll
        for (int ai = 0; ai < 2; ++ai) {
            f32x4 bs[4][2][2];
#pragma unroll
            for (int m = 0; m < 4; ++m) { const size_t off = (size_t)(u.pm * BM + ai * HALF + wr * 64 + m * 16 + fr) * D + col0;
#pragma unroll
                for (int bj = 0; bj < 2; ++bj)
#pragma unroll
                    for (int n = 0; n < 2; ++n) bs[m][bj][n] = __builtin_nontemporal_load((const f32x4*)(base + off + bj * HALF + n * 16)); }
            asm volatile("" ::: "memory");
#pragma unroll
            for (int m = 0; m < 4; ++m) { const size_t off = (size_t)(u.pm * BM + ai * HALF + wr * 64 + m * 16 + fr) * D + col0;
#pragma unroll
                for (int bj = 0; bj < 2; ++bj)
#pragma unroll
                    for (int n = 0; n < 2; ++n) __builtin_nontemporal_store(bs[m][bj][n] + gv[bj][n] * acc[ai][bj][m][n], (f32x4*)(out + off + bj * HALF + n * 16)); }
            asm volatile("" ::: "memory");
        }
    }
};


constexpr int ST_OFF = 131072;
struct OneUnit { int pm, pn; __device__ __forceinline__ bool next(int i, Unit& u) const { if (i) return false; u.pm = pm; u.pn = pn; return true; } };
struct EpiResHook {
    static constexpr bool PERM = false, AFTER_DRAIN = false;
    const float* base; float* out; const float* gate; const float* SS; const PG8_LAS float* tab;
    __device__ __forceinline__ void sums(size_t row, float& ssb, float& smla) const {
        const f32x4 a = *(const f32x4*)(SS + row * 16), b = *(const f32x4*)(SS + row * 16 + 4), c = *(const f32x4*)(SS + row * 16 + 8);
        ssb = ((a[0] + a[1]) + (a[2] + a[3])) + ((b[0] + b[1]) + (b[2] + b[3])); smla = (c[0] + c[1]) + (c[2] + c[3]);
    }
    __device__ __forceinline__ void khook(f32x4 (&acc)[2][2][4][2], const Unit& u, int t, int wr, int fr) const {
        if (t != 8) return;
#pragma unroll
        for (int ai = 0; ai < 2; ++ai)
#pragma unroll
            for (int m = 0; m < 4; ++m) { float ratio;
                if (tab) ratio = tab[ai * HALF + wr * 64 + m * 16 + fr];
                else { float ssb, smla; sums((size_t)(u.pm * BM + ai * HALF + wr * 64 + m * 16 + fr), ssb, smla); ratio = sqrtf((smla * (1.f / 512) + EPS) / (ssb * (1.f / 512) + EPS)); }
#pragma unroll
                for (int bj = 0; bj < 2; ++bj)
#pragma unroll
                    for (int n = 0; n < 2; ++n) acc[ai][bj][m][n] *= ratio; }
    }
    __device__ __forceinline__ void operator()(const f32x4 (&acc)[2][2][4][2], const Unit& u, int wr, int wc, int fr, int fq) const {
        const int b = (u.pm * BM) / SEQ, col0 = u.pn * BM + wc * 32 + 4 * fq;
        f32x4 gv[2][2];
#pragma unroll
        for (int bj = 0; bj < 2; ++bj)
#pragma unroll
            for (int n = 0; n < 2; ++n) gv[bj][n] = *(const f32x4*)(gate + (size_t)b * 6144 + col0 + bj * HALF + n * 16);
#pragma unroll
        for (int ai = 0; ai < 2; ++ai)
#pragma unroll
            for (int m = 0; m < 4; ++m) { const size_t row = (size_t)(u.pm * BM + ai * HALF + wr * 64 + m * 16 + fr), off = row * D + col0;
                float rm;
                if (tab) rm = tab[256 + ai * HALF + wr * 64 + m * 16 + fr];
                else { float ssb, smla; sums(row, ssb, smla); rm = rsqrtf(smla * (1.f / 512) + EPS); }
#pragma unroll
                for (int bj = 0; bj < 2; ++bj)
#pragma unroll
                    for (int n = 0; n < 2; ++n) { const f32x4 bs = *(const f32x4*)(base + off + bj * HALF + n * 16);
                        *(f32x4*)(out + off + bj * HALF + n * 16) = bs + gv[bj][n] * (acc[ai][bj][m][n] * rm); } }
    }
};

struct EpiResNorm {
    static constexpr bool PERM = true, AFTER_DRAIN = true;
    const float* base; float* out; const float* modp; const PG8_LAS float* tab; const float* gffn; bf16_t* Hn; unsigned* xbuf; unsigned* cnt;
    __device__ __forceinline__ void khook(f32x4 (&acc)[2][2][4][2], const Unit&, int t, int wr, int fr) const {
        if (t != 8) return;
#pragma unroll
        for (int ai = 0; ai < 2; ++ai)
#pragma unroll
            for (int m = 0; m < 4; ++m) { const float ratio = tab[ai * HALF + wr * 64 + m * 16 + fr];
#pragma unroll
                for (int bj = 0; bj < 2; ++bj)
#pragma unroll
                    for (int n = 0; n < 2; ++n) acc[ai][bj][m][n] *= ratio; }
    }
    __device__ __forceinline__ void fused(f32x4 (&acc)[2][2][4][2], const Unit& u, int wr, int wc, int fr, int fq, PG8_LAS unsigned char* lds, int lane) const {
        PG8_LAS float* P = (PG8_LAS float*)lds;
        PG8_LAS float* S = (PG8_LAS float*)(lds + 8192);
        PG8_LAS unsigned* flag = (PG8_LAS unsigned*)(lds + 8192 + 2048);
        const int wid = wr * 4 + wc, b = (u.pm * BM) / SEQ, col0 = u.pn * BM + wc * 32 + 8 * fq;
        const float* mb = modp + (size_t)b * 6144;
        {
            f32x4 gv[2][2];
#pragma unroll
            for (int bj = 0; bj < 2; ++bj)
#pragma unroll
                for (int n = 0; n < 2; ++n) gv[bj][n] = *(const f32x4*)(mb + 2 * 1024 + col0 + bj * HALF + n * 4);
#pragma unroll
            for (int ai = 0; ai < 2; ++ai)
#pragma unroll
                for (int m = 0; m < 4; ++m) { const int r = ai * HALF + wr * 64 + m * 16 + fr; const float rm = tab[256 + r]; const float* bp = base + (size_t)(u.pm * BM + r) * D + col0;
#pragma unroll
                    for (int bj = 0; bj < 2; ++bj)
#pragma unroll
                        for (int n = 0; n < 2; ++n) acc[ai][bj][m][n] = __builtin_nontemporal_load((const f32x4*)(bp + bj * HALF + n * 4)) + gv[bj][n] * (acc[ai][bj][m][n] * rm);
                    asm volatile("" : "+v"(acc[ai][0][m][0]), "+v"(acc[ai][0][m][1]), "+v"(acc[ai][1][m][0]), "+v"(acc[ai][1][m][1]));
                    if (m == 3) asm volatile("" ::: "memory"); }
        }
#pragma unroll
        for (int ai = 0; ai < 2; ++ai)
#pragma unroll
            for (int m = 0; m < 4; ++m) { float s = 0.f;
#pragma unroll
                for (int bj = 0; bj < 2; ++bj)
#pragma unroll
                    for (int n = 0; n < 2; ++n) { const f32x4 v = acc[ai][bj][m][n]; s += (v[0] * v[0] + v[1] * v[1]) + (v[2] * v[2] + v[3] * v[3]); }
                s += __shfl_xor(s, 16); s += __shfl_xor(s, 32);
                if (fq == 0) P[(ai * HALF + wr * 64 + m * 16 + fr) * 4 + wc] = s; }
        __syncthreads();
        const int row = wid * 32 + (lane & 31);
        if (lane < 32) { const float tot = (P[row * 4] + P[row * 4 + 1]) + (P[row * 4 + 2] + P[row * 4 + 3]);
            __hip_atomic_store(xbuf + ((size_t)(u.pm * BM + row) * 4 + u.pn), __float_as_uint(tot), __ATOMIC_RELAXED, __HIP_MEMORY_SCOPE_AGENT); }
        asm volatile("s_waitcnt vmcnt(0)" ::: "memory");
        if (lane == 0) __hip_atomic_fetch_add(cnt + 64 * u.pm, 1u, __ATOMIC_RELAXED, __HIP_MEMORY_SCOPE_AGENT);
        if (wid == 0) {
            unsigned ok = 0u;
            for (unsigned sp = 0; sp < (1u << 22); ++sp) {
                if ((unsigned)__builtin_amdgcn_readfirstlane(__hip_atomic_load(cnt + 64 * u.pm, __ATOMIC_RELAXED, __HIP_MEMORY_SCOPE_AGENT)) >= 32u) { ok = 1u; break; }
                __builtin_amdgcn_s_sleep(2);
            }
            __builtin_amdgcn_fence(__ATOMIC_ACQUIRE, "agent");
            if (lane == 0) flag[0] = ok;
        }
        asm volatile("s_waitcnt vmcnt(0) lgkmcnt(0)" ::: "memory");
        __syncthreads();
        if (lane < 32) { const unsigned* sl = xbuf + (size_t)(u.pm * BM + row) * 4; float t = 0.f;
#pragma unroll
            for (int j = 0; j < 4; ++j) t += __uint_as_float(__hip_atomic_load(sl + j, __ATOMIC_RELAXED, __HIP_MEMORY_SCOPE_AGENT));
            S[row] = (flag[0] != 0u) ? rsqrtf(t * (1.f / D) + EPS) : __builtin_nanf(""); }
        __syncthreads();
        {
            f32x4 gs[2][2], sh[2][2];
#pragma unroll
            for (int bj = 0; bj < 2; ++bj)
#pragma unroll
                for (int n = 0; n < 2; ++n) { const int col = col0 + bj * HALF + n * 4;
                    gs[bj][n] = *(const f32x4*)(gffn + col) * (*(const f32x4*)(mb + 4 * 1024 + col) + 1.f); sh[bj][n] = *(const f32x4*)(mb + 3 * 1024 + col); }
#pragma unroll
            for (int ai = 0; ai < 2; ++ai)
#pragma unroll
                for (int m = 0; m < 4; ++m) { const int r = ai * HALF + wr * 64 + m * 16 + fr; const size_t off = (size_t)(u.pm * BM + r) * D + col0; const float rs = S[r];
#pragma unroll
                    for (int bj = 0; bj < 2; ++bj) { const f32x4 xa = acc[ai][bj][m][0], xb = acc[ai][bj][m][1];
                        __builtin_nontemporal_store(xa, (f32x4*)(out + off + bj * HALF)); __builtin_nontemporal_store(xb, (f32x4*)(out + off + bj * HALF + 4));
                        const f32x4 ha = xa * rs * gs[bj][0] + sh[bj][0], hb = xb * rs * gs[bj][1] + sh[bj][1];
                        u32x4 w; w.x = cvt_pk_bf16(ha[0], ha[1]); w.y = cvt_pk_bf16(ha[2], ha[3]); w.z = cvt_pk_bf16(hb[0], hb[1]); w.w = cvt_pk_bf16(hb[2], hb[3]);
                        *(u32x4*)(Hn + off + bj * HALF) = w; }
                    if (m & 1) asm volatile("" ::: "memory"); }
        }
    }
};
struct EpiQ {
    static constexpr bool PERM = true, AFTER_DRAIN = true;
    bf16_t* QM; const float* q_norm; const float* COS; const float* SIN;
    __device__ __forceinline__ void khook(f32x4 (&)[2][2][4][2], const Unit&, int, int, int) const {}
    __device__ __forceinline__ void fused(f32x4 (&acc)[2][2][4][2], const Unit& u, int wr, int wc, int fr, int fq, PG8_LAS unsigned char* lds, int lane) const {
        const PG8_LAS float* st = (const PG8_LAS float*)(lds + ST_OFF);
        PG8_LAS float* P = (PG8_LAS float*)lds;
        PG8_LAS float* X = (PG8_LAS float*)(lds + 8192);
#pragma unroll
        for (int ai = 0; ai < 2; ++ai)
#pragma unroll
            for (int m = 0; m < 4; ++m) { const int r = ai * HALF + wr * 64 + m * 16 + fr; const float rs = st[r]; float s = 0.f;
#pragma unroll
                for (int bj = 0; bj < 2; ++bj)
#pragma unroll
                    for (int n = 0; n < 2; ++n) { f32x4 v = acc[ai][bj][m][n] * rs; acc[ai][bj][m][n] = v; s += (v[0] * v[0] + v[1] * v[1]) + (v[2] * v[2] + v[3] * v[3]); }
                s += __shfl_xor(s, 16); s += __shfl_xor(s, 32);
                if (fq == 0) P[r * 4 + wc] = s; }
        __syncthreads();
        f32x4 g[2][2];
#pragma unroll
        for (int bj = 0; bj < 2; ++bj)
#pragma unroll
            for (int n = 0; n < 2; ++n) { const int j0 = bj * HALF + wc * 32 + 8 * fq + 4 * n; g[bj][n] = (j0 < MQK) ? *(const f32x4*)(q_norm + j0) : (f32x4){0.f, 0.f, 0.f, 0.f}; }
#pragma unroll
        for (int ai = 0; ai < 2; ++ai)
#pragma unroll
            for (int m = 0; m < 4; ++m) { const int r = ai * HALF + wr * 64 + m * 16 + fr;
                const float tot = (P[r * 4] + P[r * 4 + 1]) + (P[r * 4 + 2] + P[r * 4 + 3]);
                const float rq = rsqrtf(tot * (1.f / MQK) + EPS) * 0.10411754714f;
#pragma unroll
                for (int bj = 0; bj < 2; ++bj)
#pragma unroll
                    for (int n = 0; n < 2; ++n) acc[ai][bj][m][n] = acc[ai][bj][m][n] * g[bj][n] * rq; }
        if (wc < 2) {
#pragma unroll
            for (int ai = 0; ai < 2; ++ai)
#pragma unroll
                for (int m = 0; m < 4; ++m)
#pragma unroll
                    for (int n = 0; n < 2; ++n)
#pragma unroll
                        for (int i = 0; i < 4; ++i) X[((wr * 2 + wc) * 64 + (ai * 4 + m) * 8 + n * 4 + i) * 64 + lane] = acc[ai][1][m][n][i];
        }
        __syncthreads();
        if (wc < 2) {
#pragma unroll
            for (int ai = 0; ai < 2; ++ai)
#pragma unroll
                for (int m = 0; m < 4; ++m) { const size_t row = (size_t)(u.pm * BM + ai * HALF + wr * 64 + m * 16 + fr);
#pragma unroll
                    for (int n = 0; n < 2; ++n) { const f32x4 cs = *(const f32x4*)(COS + row * 32 + 8 * fq + 4 * n), sn = *(const f32x4*)(SIN + row * 32 + 8 * fq + 4 * n);
                        f32x4 v = acc[ai][1][m][n];
#pragma unroll
                        for (int i = 0; i < 4; ++i) { const float part = X[((wr * 2 + (1 - wc)) * 64 + (ai * 4 + m) * 8 + n * 4 + i) * 64 + lane];
                            v[i] = (wc == 0) ? (v[i] * cs[i] - part * sn[i]) : (v[i] * cs[i] + part * sn[i]); }
                        acc[ai][1][m][n] = v; } }
        }
#pragma unroll
        for (int ai = 0; ai < 2; ++ai)
#pragma unroll
            for (int m = 0; m < 4; ++m) { const size_t row = (size_t)(u.pm * BM + ai * HALF + wr * 64 + m * 16 + fr);
                bf16_t* rowp = QM + (row * 4 + u.pn) * MQK + wc * 32 + 8 * fq;
#pragma unroll
                for (int bj = 0; bj < 2; ++bj) { if (bj == 1 && wc >= 2) continue;
                    const f32x4 v0 = acc[ai][bj][m][0], v1 = acc[ai][bj][m][1];
                    u32x4 w; w.x = cvt_pk_bf16(v0[0], v0[1]); w.y = cvt_pk_bf16(v0[2], v0[3]); w.z = cvt_pk_bf16(v1[0], v1[1]); w.w = cvt_pk_bf16(v1[2], v1[3]);
                    *(u32x4*)(rowp + bj * HALF) = w; } }
        __syncthreads();
    }
};
struct EpiKV {
    static constexpr bool PERM = true, AFTER_DRAIN = true;
    bf16_t* KM; bf16_t* VM; const float* k_nope_norm;
    __device__ __forceinline__ void khook(f32x4 (&)[2][2][4][2], const Unit&, int, int, int) const {}
    __device__ __forceinline__ void fused(f32x4 (&acc)[2][2][4][2], const Unit& u, int wr, int wc, int fr, int fq, PG8_LAS unsigned char* lds, int lane) const {
        const PG8_LAS float* st = (const PG8_LAS float*)(lds + ST_OFF) + 256;
        PG8_LAS float* P = (PG8_LAS float*)lds;
#pragma unroll
        for (int ai = 0; ai < 2; ++ai)
#pragma unroll
            for (int m = 0; m < 4; ++m) { const int r = ai * HALF + wr * 64 + m * 16 + fr; const float rs = st[r]; float s = 0.f;
#pragma unroll
                for (int bj = 0; bj < 2; ++bj)
#pragma unroll
                    for (int n = 0; n < 2; ++n) { f32x4 v = acc[ai][bj][m][n] * rs; acc[ai][bj][m][n] = v; if (bj == 0) s += (v[0] * v[0] + v[1] * v[1]) + (v[2] * v[2] + v[3] * v[3]); }
                s += __shfl_xor(s, 16); s += __shfl_xor(s, 32);
                if (fq == 0) P[r * 4 + wc] = s; }
        __syncthreads();
        f32x4 g[2];
#pragma unroll
        for (int n = 0; n < 2; ++n) g[n] = *(const f32x4*)(k_nope_norm + wc * 32 + 8 * fq + 4 * n);
#pragma unroll
        for (int ai = 0; ai < 2; ++ai)
#pragma unroll
            for (int m = 0; m < 4; ++m) { const int r = ai * HALF + wr * 64 + m * 16 + fr; const size_t row = (size_t)(u.pm * BM + r);
                const float tot = (P[r * 4] + P[r * 4 + 1]) + (P[r * 4 + 2] + P[r * 4 + 3]);
                const float rk = rsqrtf(tot * (1.f / MNOPE) + EPS);
                const f32x4 k0 = acc[ai][0][m][0] * g[0] * rk, k1 = acc[ai][0][m][1] * g[1] * rk, v0 = acc[ai][1][m][0], v1 = acc[ai][1][m][1];
                u32x4 w; w.x = cvt_pk_bf16(k0[0], k0[1]); w.y = cvt_pk_bf16(k0[2], k0[3]); w.z = cvt_pk_bf16(k1[0], k1[1]); w.w = cvt_pk_bf16(k1[2], k1[3]);
                *(u32x4*)(KM + (row * 4 + u.pn) * MQK + wc * 32 + 8 * fq) = w;
                w.x = cvt_pk_bf16(v0[0], v0[1]); w.y = cvt_pk_bf16(v0[2], v0[3]); w.z = cvt_pk_bf16(v1[0], v1[1]); w.w = cvt_pk_bf16(v1[2], v1[3]);
                *(u32x4*)(VM + (row * 4 + u.pn) * MV + wc * 32 + 8 * fq) = w; }
        __syncthreads();
    }
};

template <class Epi, class Sched, bool ALIGN_EPI, int AUXA = 0>
__device__ __forceinline__ void gemm_phase(PG8_LAS unsigned char* lds, const Gemm g, const Sched& S, const Epi& E) {
    int tid_ = threadIdx.x; asm volatile("" : "+v"(tid_));
    const int tid = tid_, wid = __builtin_amdgcn_readfirstlane(tid >> 6), lane = tid & 63, wr = wid >> 2, wc = wid & 3, fr = lane & 15, fq = lane >> 4;
    const int K = g.K, nt = K / BK, lda = g.lda;
    unsigned voffA[2], voffB[2];
#pragma unroll
    for (int i = 0; i < 2; ++i) { int R, C; stage_rc(tid * 16 + i * 8192, R, C); const int Rb = Epi::PERM ? ((R & ~31) + perm32(R & 31)) : R;
        voffA[i] = (unsigned)(R * lda + C) * 2u; voffB[i] = (unsigned)(Rb * K + C) * 2u; }
    const size_t kstep = (size_t)(BK * 2);
    const size_t hstepA = (size_t)HALF * lda * 2, hstepB = (size_t)HALF * K * 2;
    const size_t tstepA = 2 * hstepA, tstepB = 2 * hstepB;
    const unsigned ldsw = (unsigned)wid * 1024u;
    const int aoff = lds_byte(wr * 64 + fr, fq * 8), boff = lds_byte(wc * 32 + fr, fq * 8);
#define PG8_SA(b, h) (((b) * 2 + (h)) * HTB)
#define PG8_SB(b, h) ((4 + (b) * 2 + (h)) * HTB)
#define PG8_STAGE(bufoff, gbase, voff) do { _Pragma("unroll") for (int _i = 0; _i < 2; ++_i) \
        __builtin_amdgcn_global_load_lds((const unsigned*)((const char*)(gbase) + (voff)[_i]), (PG8_LAS unsigned*)(lds + (bufoff) + ldsw + _i * 8192), 16, 0, ((bufoff) < 4 * HTB) ? AUXA : 0); } while (0)
#define PG8_LDA(dst, b, h) do { _Pragma("unroll") for (int m = 0; m < 4; ++m) _Pragma("unroll") for (int k = 0; k < 2; ++k) dst[m][k] = *(const PG8_LAS bf16x8*)(lds + PG8_SA(b, h) + aoff + m * 2048 + k * 1024); } while (0)
#define PG8_LDB(dst, b, h) do { _Pragma("unroll") for (int n = 0; n < 2; ++n) _Pragma("unroll") for (int k = 0; k < 2; ++k) dst[n][k] = *(const PG8_LAS bf16x8*)(lds + PG8_SB(b, h) + boff + n * 2048 + k * 1024); } while (0)
#define PG8_MMA(ai, bj, At, Bt) do { __builtin_amdgcn_s_setprio(1); _Pragma("unroll") for (int m = 0; m < 4; ++m) _Pragma("unroll") for (int n = 0; n < 2; ++n) _Pragma("unroll") for (int k = 0; k < 2; ++k) \
        acc[ai][bj][m][n] = __builtin_amdgcn_mfma_f32_16x16x32_bf16(Bt[n][k], At[m][k], acc[ai][bj][m][n], 0, 0, 0); __builtin_amdgcn_s_setprio(0); } while (0)
#define PG8_WAIT_V(n) asm volatile("s_waitcnt vmcnt(" #n ")" ::: "memory")
#define PG8_WAIT_L(n) asm volatile("s_waitcnt lgkmcnt(" #n ")" ::: "memory")
#define PG8_BAR __builtin_amdgcn_s_barrier()
#define PG8_SCHED __builtin_amdgcn_sched_barrier(0)
    Unit cur, nxt; int ui = 0;
    if (!S.next(0, cur)) return;
    f32x4 acc[2][2][4][2];
#pragma unroll
    for (int a = 0; a < 2; ++a)
#pragma unroll
        for (int b = 0; b < 2; ++b)
#pragma unroll
            for (int m = 0; m < 4; ++m)
#pragma unroll
                for (int n = 0; n < 2; ++n) acc[a][b][m][n] = (f32x4){0.f, 0.f, 0.f, 0.f};
    bf16x8 At[4][2], B0[2][2], B1[2][2];
    const char* cA = (const char*)g.A + (size_t)cur.pm * tstepA; const char* cB = (const char*)g.Bt + (size_t)cur.pn * tstepB;
    PG8_STAGE(PG8_SB(0, 0), cB, voffB); PG8_STAGE(PG8_SB(0, 1), cB + hstepB, voffB); PG8_STAGE(PG8_SA(0, 0), cA, voffA); PG8_STAGE(PG8_SA(0, 1), cA + hstepA, voffA);
    if (wr == 1) PG8_BAR;
    PG8_WAIT_V(2); PG8_BAR;
    PG8_STAGE(PG8_SB(1, 0), cB + kstep, voffB); PG8_STAGE(PG8_SA(1, 0), cA + kstep, voffA); PG8_STAGE(PG8_SB(1, 1), cB + hstepB + kstep, voffB);
    PG8_WAIT_V(6); PG8_BAR;
    for (;;) {
        const bool has_next = S.next(ui + 1, nxt);
        const char* nA = has_next ? (const char*)g.A + (size_t)nxt.pm * tstepA : cA; const char* nB = has_next ? (const char*)g.Bt + (size_t)nxt.pn * tstepB : cB;
#pragma nounroll
        for (int t = 0; t < nt; t += 2) {
            const bool last = (t == nt - 2);
            const char* a1 = cA + (size_t)(t + 1) * kstep;
            const char* a2 = last ? nA : cA + (size_t)(t + 2) * kstep; const char* b2 = last ? nB : cB + (size_t)(t + 2) * kstep;
            const char* a3 = a2 + kstep; const char* b3 = b2 + kstep;
            E.khook(acc, cur, t, wr, fr);
            PG8_LDB(B0, 0, 0); PG8_LDB(B1, 0, 1); PG8_SCHED; PG8_LDA(At, 0, 0); PG8_STAGE(PG8_SA(1, 1), a1 + hstepA, voffA);
            PG8_WAIT_V(8); PG8_WAIT_L(0); PG8_BAR; PG8_MMA(0, 0, At, B0); PG8_MMA(0, 1, At, B1); PG8_BAR; PG8_SCHED;
            PG8_LDA(At, 0, 1); PG8_STAGE(PG8_SB(0, 0), b2, voffB); PG8_STAGE(PG8_SB(0, 1), b2 + hstepB, voffB); PG8_STAGE(PG8_SA(0, 0), a2, voffA);
            PG8_WAIT_V(8); PG8_WAIT_L(0); PG8_BAR; PG8_MMA(1, 0, At, B0); PG8_MMA(1, 1, At, B1); PG8_BAR; PG8_SCHED;
            PG8_LDB(B0, 1, 0); PG8_LDB(B1, 1, 1); PG8_SCHED; PG8_LDA(At, 1, 0); PG8_STAGE(PG8_SA(0, 1), a2 + hstepA, voffA);
            PG8_WAIT_V(8); PG8_WAIT_L(0); PG8_BAR; PG8_MMA(0, 0, At, B0); PG8_MMA(0, 1, At, B1); PG8_BAR; PG8_SCHED;
            PG8_LDA(At, 1, 1); PG8_STAGE(PG8_SB(1, 0), b3, voffB); PG8_STAGE(PG8_SB(1, 1), b3 + hstepB, voffB); PG8_STAGE(PG8_SA(1, 0), a3, voffA);
            PG8_WAIT_V(8); PG8_WAIT_L(0); PG8_BAR; PG8_MMA(1, 0, At, B0); PG8_MMA(1, 1, At, B1); PG8_BAR; PG8_SCHED;
        }
        if constexpr (ALIGN_EPI) { if (wr == 0) PG8_BAR; }
        if constexpr (!Epi::AFTER_DRAIN) E(acc, cur, wr, wc, fr, fq);
        if (!has_next) break;
#pragma unroll
        for (int a = 0; a < 2; ++a)
#pragma unroll
            for (int b = 0; b < 2; ++b)
#pragma unroll
                for (int m = 0; m < 4; ++m)
#pragma unroll
                    for (int n = 0; n < 2; ++n) acc[a][b][m][n] = (f32x4){0.f, 0.f, 0.f, 0.f};
        cur = nxt; cA = nA; cB = nB; ++ui;
        if constexpr (ALIGN_EPI) { if (wr == 1) PG8_BAR; }
    }
    PG8_WAIT_V(0);
    if constexpr (!ALIGN_EPI) { if (wr == 0) PG8_BAR; }
    PG8_BAR;
    if constexpr (Epi::AFTER_DRAIN) E.fused(acc, cur, wr, wc, fr, fq, lds, lane);
#undef PG8_SA
#undef PG8_SB
#undef PG8_STAGE
#undef PG8_LDA
#undef PG8_LDB
#undef PG8_MMA
#undef PG8_WAIT_V
#undef PG8_WAIT_L
#undef PG8_BAR
#undef PG8_SCHED
}
}


namespace att {
typedef short bf16x8 __attribute__((ext_vector_type(8)));
typedef short s16x4 __attribute__((ext_vector_type(4)));
typedef _Float16 f16x8 __attribute__((ext_vector_type(8)));
typedef _Float16 f16x2 __attribute__((ext_vector_type(2)));
typedef float f32x16 __attribute__((ext_vector_type(16)));
typedef float f32x2v __attribute__((ext_vector_type(2)));
typedef __bf16 bf16x2_t __attribute__((ext_vector_type(2)));
constexpr int BUFB = 46080, KV_OFF = 25600;
constexpr int WS_OFF = 136192, SLOT_OFF = WS_OFF + 2048, FLAG_OFF = SLOT_OFF + 64;
__device__ __forceinline__ int crow(int r, int hi) { return (r & 3) + 8 * (r >> 2) + 4 * hi; }
__device__ __forceinline__ constexpr int crowc(int r) { return (r & 3) + 8 * (r >> 2); }
__device__ __forceinline__ unsigned cvtpk_bf16(float lo, float hi) { f32x2v v = {lo, hi}; bf16x2_t b = __builtin_convertvector(v, bf16x2_t); return __builtin_bit_cast(unsigned, b); }
__device__ __forceinline__ unsigned cvtpk_f16(float lo, float hi) { f32x2v v = {lo, hi}; f16x2 b = __builtin_convertvector(v, f16x2); return __builtin_bit_cast(unsigned, b); }
#define ATT_EX2(x) __builtin_amdgcn_exp2f(x)
#define ATT_LG2(x) __builtin_amdgcn_logf(x)

template <int DQK, int DV> struct TileRegs { v4u k[DQK / 64]; v4u v[DV / 64]; };
template <int DQK, int DV>
__device__ __forceinline__ void tile_load(TileRegs<DQK, DV>& R, const bf16_t* Kg, int ks, const bf16_t* Vg, int vs, int k0, int) {
    const int tid = tid_now();
#pragma unroll
    for (int i = 0; i < DQK / 64; ++i) { const int ch = tid + 512 * i, row = ch / (DQK / 8), c = ch % (DQK / 8); R.k[i] = *(const v4u*)(Kg + (size_t)(k0 + row) * ks + c * 8); }
#pragma unroll
    for (int i = 0; i < DV / 64; ++i) { const int ch = tid + 512 * i, row = ch / (DV / 8), c = ch % (DV / 8); R.v[i] = *(const v4u*)(Vg + (size_t)(k0 + row) * vs + c * 8); }
}
template <int DQK, int DV>
__device__ __forceinline__ void tile_store(const TileRegs<DQK, DV>& R, LAS unsigned char* buf, int, const int voff = KV_OFF) {
    const int tid = tid_now();
    constexpr int KROWB = (DQK + 8) * 2, VROWB = (DV + 32) * 2;
#pragma unroll
    for (int i = 0; i < DQK / 64; ++i) { const int ch = tid + 512 * i, row = ch / (DQK / 8), c = ch % (DQK / 8); *(LAS v4u*)(buf + row * KROWB + c * 16) = R.k[i]; }
#pragma unroll
    for (int i = 0; i < DV / 64; ++i) { const int ch = tid + 512 * i, row = ch / (DV / 8), c = ch % (DV / 8); *(LAS v4u*)(buf + voff + row * VROWB + c * 16) = R.v[i]; }
}
typedef short v4i16_t __attribute__((ext_vector_type(4)));
__device__ __forceinline__ s16x4 vtr(const LAS unsigned char* p) { return __builtin_bit_cast(s16x4, __builtin_amdgcn_ds_read_tr16_b64_v4i16((LAS v4i16_t*)p)); }
template <int VROWB>
__device__ __forceinline__ bf16x8 vfrag(const LAS unsigned char* vb, int db, int p, int s2) {
    const s16x4 lo = vtr(vb + (32 * p + 16 * s2) * VROWB + 64 * db);
    const s16x4 hi = vtr(vb + (32 * p + 16 * s2 + 8) * VROWB + 64 * db);
    return (bf16x8){lo[0], lo[1], lo[2], lo[3], hi[0], hi[1], hi[2], hi[3]};
}
#define ATT_PACK8(X, B) __builtin_bit_cast(bf16x8, (v4u){cvtpk_bf16(X[B], X[B + 1]), cvtpk_bf16(X[B + 2], X[B + 3]), cvtpk_bf16(X[B + 4], X[B + 5]), cvtpk_bf16(X[B + 6], X[B + 7])})
#define ATT_PACKH8(X, B) __builtin_bit_cast(f16x8, (v4u){cvtpk_f16(X[B], X[B + 1]), cvtpk_f16(X[B + 2], X[B + 3]), cvtpk_f16(X[B + 4], X[B + 5]), cvtpk_f16(X[B + 6], X[B + 7])})

__device__ __forceinline__ void sb_tile(const bool DIAG, const LAS unsigned char* lds, const int voff, const bf16x8 (&qf)[4], const f16x8 (&Ud)[2], f16x8 ones, f32x16& o0, f32x16& o1, float& carry, int k0, int qw0, int r32, int hi) {
    constexpr int KROWB = 144;
    f32x16 p0 = {}, p1 = {};
    const LAS unsigned char* kb = lds + r32 * KROWB + hi * 16;
#pragma unroll
    for (int s = 0; s < 4; ++s) {
        const bf16x8 a0 = *(const LAS bf16x8*)(kb + s * 32), a1 = *(const LAS bf16x8*)(kb + 32 * KROWB + s * 32);
        p0 = __builtin_amdgcn_mfma_f32_32x32x16_bf16(a0, qf[s], p0, 0, 0, 0);
        p1 = __builtin_amdgcn_mfma_f32_32x32x16_bf16(a1, qf[s], p1, 0, 0, 0);
    }
    const int qrel = qw0 + r32 - k0 - 4 * hi;
    f32x16 c0, c1, lm0, lm1;
    float lb00;
#pragma unroll
    for (int r = 0; r < 16; ++r) {
        { const float z = p0[r], e = ATT_EX2(-__builtin_fabsf(z)), lp = ATT_LG2(1.0f + e); const float mn = __builtin_amdgcn_fmed3f(z, -INFINITY, 0.0f);
          const float lb = mn - lp; lm0[r] = lb - z; c0[r] = lb + carry; if (r == 0) lb00 = lb; }
        { const float z = p1[r], e = ATT_EX2(-__builtin_fabsf(z)), lp = ATT_LG2(1.0f + e); const float mn = __builtin_amdgcn_fmed3f(z, -INFINITY, 0.0f);
          const float lb = mn - lp; lm1[r] = lb - z; c1[r] = lb + carry; }
    }
    if (DIAG) {
#pragma unroll
        for (int r = 0; r < 16; ++r) { lm0[r] = (crowc(r) < qrel) ? lm0[r] : 0.f; lm1[r] = (32 + crowc(r) < qrel) ? lm1[r] : 0.f; }
    }
    const f16x8 L00 = ATT_PACKH8(lm0, 0), L01 = ATT_PACKH8(lm0, 8), L10 = ATT_PACKH8(lm1, 0), L11 = ATT_PACKH8(lm1, 8);
    c0 = __builtin_amdgcn_mfma_f32_32x32x16_f16(Ud[0], L00, c0, 0, 0, 0);
    c1 = __builtin_amdgcn_mfma_f32_32x32x16_f16(Ud[0], L10, c1, 0, 0, 0);
    c0 = __builtin_amdgcn_mfma_f32_32x32x16_f16(Ud[1], L01, c0, 0, 0, 0);
    c1 = __builtin_amdgcn_mfma_f32_32x32x16_f16(Ud[1], L11, c1, 0, 0, 0);
    c0 = __builtin_amdgcn_mfma_f32_32x32x16_f16(ones, L10, c0, 0, 0, 0);
    c0 = __builtin_amdgcn_mfma_f32_32x32x16_f16(ones, L11, c0, 0, 0, 0);
    carry = __shfl((c0[0] - lb00) + lm0[0], r32);
    f32x16 w0, w1;
#pragma unroll
    for (int r = 0; r < 16; ++r) { w0[r] = ATT_EX2(c0[r]); w1[r] = ATT_EX2(c1[r]); }
    if (DIAG) {
#pragma unroll
        for (int r = 0; r < 16; ++r) { w0[r] = (crowc(r) < qrel) ? w0[r] : 0.f; w1[r] = (32 + crowc(r) < qrel) ? w1[r] : 0.f; }
    }
    const bf16x8 W00 = ATT_PACK8(w0, 0), W01 = ATT_PACK8(w0, 8), W10 = ATT_PACK8(w1, 0), W11 = ATT_PACK8(w1, 8);
    const int lane_ = r32 + 32 * hi;
    const LAS unsigned char* vb = lds + voff + (4 * hi + ((lane_ & 15) >> 2)) * 192 + 32 * ((lane_ >> 4) & 1) + 8 * (lane_ & 3);
#define vfrag vfrag<192>
    o0 = __builtin_amdgcn_mfma_f32_32x32x16_bf16(W00, vfrag(vb, 0, 0, 0), o0, 0, 0, 0);
    o1 = __builtin_amdgcn_mfma_f32_32x32x16_bf16(W00, vfrag(vb, 1, 0, 0), o1, 0, 0, 0);
    o0 = __builtin_amdgcn_mfma_f32_32x32x16_bf16(W01, vfrag(vb, 0, 0, 1), o0, 0, 0, 0);
    o1 = __builtin_amdgcn_mfma_f32_32x32x16_bf16(W01, vfrag(vb, 1, 0, 1), o1, 0, 0, 0);
    o0 = __builtin_amdgcn_mfma_f32_32x32x16_bf16(W10, vfrag(vb, 0, 1, 0), o0, 0, 0, 0);
    o1 = __builtin_amdgcn_mfma_f32_32x32x16_bf16(W10, vfrag(vb, 1, 1, 0), o1, 0, 0, 0);
    o0 = __builtin_amdgcn_mfma_f32_32x32x16_bf16(W11, vfrag(vb, 0, 1, 1), o0, 0, 0, 0);
    o1 = __builtin_amdgcn_mfma_f32_32x32x16_bf16(W11, vfrag(vb, 1, 1, 1), o1, 0, 0, 0);
#undef vfrag
}
__device__ __forceinline__ void sb_unit(LAS unsigned char* lds, const bf16_t* PROJ, bf16_t* O, float* SS, int b, int h, int qb) {
    const int tid = threadIdx.x, lane = tid & 63, r32 = lane & 31, hi = lane >> 5, wid = __builtin_amdgcn_readfirstlane(tid >> 6);
    const int q0 = qb * 256, qw0 = q0 + 32 * wid;
    const bf16_t* Qg = PROJ + (size_t)(b * SEQ) * NPROJ + h * 64; const bf16_t* Kg = Qg + 512; const bf16_t* Vg = Qg + 1024;
    bf16x8 qf[4];
#pragma unroll
    for (int s = 0; s < 4; ++s) qf[s] = *(const bf16x8*)(Qg + (size_t)(qw0 + r32) * NPROJ + 16 * s + 8 * hi);
    f16x8 Ud[2], ones;
#pragma unroll
    for (int s2 = 0; s2 < 2; ++s2)
#pragma unroll
        for (int e = 0; e < 8; ++e) Ud[s2][e] = ((16 * s2 + 8 * (e >> 2) + 4 * hi + (e & 3)) > r32) ? (_Float16)1.0f : (_Float16)0.0f;
#pragma unroll
    for (int e = 0; e < 8; ++e) ones[e] = (_Float16)1.0f;
    f32x16 o0 = {}, o1 = {}; float carry = 0.f;
    constexpr int SBB = 21504, SBV = 9216, NS = 6;
    const int T0 = 4 * qb, Tw = T0 + (wid >> 1), nstep = T0 + 4;
    {
        TileRegs<64, 64> P[4];
#pragma unroll
        for (int jj = 0; jj < 4; ++jj) tile_load<64, 64>(P[jj], Kg, NPROJ, Vg, NPROJ, (T0 + jj) * 64, tid);
#pragma unroll
        for (int jj = 0; jj < 4; ++jj) tile_store<64, 64>(P[jj], lds + ((T0 + jj) % NS) * SBB, tid, SBV);
    }
    TileRegs<64, 64> R;
    if (T0 >= 1) tile_load<64, 64>(R, Kg, NPROJ, Vg, NPROJ, (T0 - 1) * 64, tid);
    LAS unsigned* flags = (LAS unsigned*)(lds + FLAG_OFF);
    bool dead = false;
    if (lane == 0) flags[8 + wid] = 0u;
    for (int i = 0; i < nstep; ++i) {
        __syncthreads();
        { const LAS unsigned* fl = flags + ((i + 1) & 1) * 8;
          const unsigned all = fl[0] & fl[1] & fl[2] & fl[3] & fl[4] & fl[5] & fl[6] & fl[7];
          if (all) break; }
        const int tn = T0 - i - 1;
        if (tn >= 0) { tile_store<64, 64>(R, lds + (tn % NS) * SBB, tid, SBV); if (tn >= 1) tile_load<64, 64>(R, Kg, NPROJ, Vg, NPROJ, (tn - 1) * 64, tid); }
        const int T = Tw - i;
        if (T >= 0 && !dead) {
            sb_tile(i == 0, lds + (T % NS) * SBB, SBV, qf, Ud, ones, o0, o1, carry, T * 64, qw0, r32, hi);
            dead = !__any(carry >= -160.f);
        }
        if (lane == 0) flags[(i & 1) * 8 + wid] = (dead || T < 1) ? 1u : 0u;
    }
#pragma unroll
    for (int r = 0; r < 16; ++r) {
        const size_t row = (size_t)b * SEQ + qw0 + crow(r, hi);
        O[row * D + h * 64 + r32] = (bf16_t)f2bf(o0[r]); O[row * D + h * 64 + 32 + r32] = (bf16_t)f2bf(o1[r]);
        float ss = o0[r] * o0[r] + o1[r] * o1[r];
        ss += __shfl_xor(ss, 1); ss += __shfl_xor(ss, 2); ss += __shfl_xor(ss, 4); ss += __shfl_xor(ss, 8); ss += __shfl_xor(ss, 16);
        if (r32 == 0) SS[row * 16 + h] = ss;
    }
}

__device__ __forceinline__ void mla_half(const bool DIAG, const int p, const LAS unsigned char* lds, LAS float* wsf, const bf16x8 (&qf)[12], f32x16 (&o)[4], float& m_run, float& l_run, int k0, int qw0, int r32, int hi) {
    constexpr int KROWB = 400;
    f32x16 p0 = {};
    const LAS unsigned char* kb = lds + (32 * p + r32) * KROWB + hi * 16;
    bf16x8 ka[4];
    ka[0] = *(const LAS bf16x8*)(kb); ka[1] = *(const LAS bf16x8*)(kb + 32); ka[2] = *(const LAS bf16x8*)(kb + 64);
#pragma unroll
    for (int s = 0; s < 12; ++s) {
        if (s + 3 < 12) ka[(s + 3) & 3] = *(const LAS bf16x8*)(kb + (s + 3) * 32);
        __builtin_amdgcn_sched_barrier(0);
        p0 = __builtin_amdgcn_mfma_f32_32x32x16_bf16(ka[s & 3], qf[s], p0, 0, 0, 0);
        __builtin_amdgcn_sched_barrier(0);
    }
    if (DIAG) {
        const int qrel = qw0 + r32 - k0 - 32 * p - 4 * hi;
#pragma unroll
        for (int r = 0; r < 16; ++r) { if (crowc(r) > qrel) p0[r] = -INFINITY; }
    }
    float mt = p0[0];
#pragma unroll
    for (int r = 1; r < 16; ++r) mt = __builtin_fmaxf(mt, p0[r]);
    mt = __builtin_fmaxf(mt, __shfl_xor(mt, 32));
    if (__any(mt > m_run)) {
        const float mn = __builtin_fmaxf(m_run, mt), corr = ATT_EX2(m_run - mn);
        m_run = mn;
        l_run *= corr;
        if (hi == 0) wsf[r32] = corr;
        const LAS float* wsfh = wsf + 4 * hi;
#pragma unroll
        for (int r = 0; r < 16; ++r) { const float f = wsfh[crowc(r)];
#pragma unroll
            for (int db = 0; db < 4; ++db) o[db][r] *= f; }
    }
    float rs = 0.f;
#pragma unroll
    for (int r = 0; r < 16; ++r) { p0[r] = ATT_EX2(p0[r] - m_run); rs += p0[r]; }
    l_run += rs;
    const bf16x8 W0 = ATT_PACK8(p0, 0), W1 = ATT_PACK8(p0, 8);
    const int lane_ = r32 + 32 * hi;
    const LAS unsigned char* vb = lds + KV_OFF + (4 * hi + ((lane_ & 15) >> 2)) * 320 + 32 * ((lane_ >> 4) & 1) + 8 * (lane_ & 3);
    bf16x8 vf[3];
    vf[0] = vfrag<320>(vb, 0, p, 0); vf[1] = vfrag<320>(vb, 0, p, 1);
#pragma unroll
    for (int i = 0; i < 8; ++i) {
        if (i + 2 < 8) vf[(i + 2) % 3] = vfrag<320>(vb, (i + 2) >> 1, p, (i + 2) & 1);
        __builtin_amdgcn_sched_barrier(0);
        o[i >> 1] = __builtin_amdgcn_mfma_f32_32x32x16_bf16((i & 1) ? W1 : W0, vf[i % 3], o[i >> 1], 0, 0, 0);
        __builtin_amdgcn_sched_barrier(0);
    }
}
__device__ __forceinline__ void mla_unit(LAS unsigned char* lds, const bf16_t* QM, const bf16_t* KM, const bf16_t* VM, bf16_t* O, float* SS, int b, int h, int qb) {
    const int tid = threadIdx.x, lane = tid & 63, r32 = lane & 31, hi = lane >> 5, wid = __builtin_amdgcn_readfirstlane(tid >> 6);
    const int q0 = qb * 256, qw0 = q0 + 32 * wid;
    const bf16_t* Qg = QM + ((size_t)(b * SEQ) * 4 + h) * MQK; const bf16_t* Kg = KM + ((size_t)(b * SEQ) * 4 + h) * MQK; const bf16_t* Vg = VM + ((size_t)(b * SEQ) * 4 + h) * MV;
    LAS float* wsf = (LAS float*)(lds + WS_OFF) + wid * 64;
    bf16x8 qf[12];
#pragma unroll
    for (int s = 0; s < 12; ++s) qf[s] = *(const bf16x8*)(Qg + (size_t)(qw0 + r32) * (4 * MQK) + 16 * s + 8 * hi);
    f32x16 o[4] = {{}, {}, {}, {}}; float m_run = -INFINITY, l_run = 0.f;
    const int ntile = (q0 + 256) / 64;
    TileRegs<192, 128> R;
    tile_load<192, 128>(R, Kg, 4 * MQK, Vg, 4 * MV, 0, tid);
    tile_store<192, 128>(R, lds, tid);
    tile_load<192, 128>(R, Kg, 4 * MQK, Vg, 4 * MV, 64, tid);
    for (int t = 0; t < ntile; ++t) {
        __syncthreads();
        if (t + 1 < ntile) { tile_store<192, 128>(R, lds + ((t + 1) & 1) * BUFB, tid); if (t + 2 < ntile) tile_load<192, 128>(R, Kg, 4 * MQK, Vg, 4 * MV, (t + 2) * 64, tid); }
        const int k0 = t * 64;
        const LAS unsigned char* buf = lds + (t & 1) * BUFB;
        if (k0 <= qw0 + 31) {
            mla_half(k0 + 31 > qw0, 0, buf, wsf, qf, o, m_run, l_run, k0, qw0, r32, hi);
            if (k0 + 32 <= qw0 + 31) mla_half(k0 + 63 > qw0, 1, buf, wsf, qf, o, m_run, l_run, k0, qw0, r32, hi);
        }
    }
    const float lt = l_run + __shfl_xor(l_run, 32);
    if (hi == 0) wsf[r32] = 1.0f / lt;
    float f[16];
#pragma unroll
    for (int r = 0; r < 16; ++r) f[r] = wsf[crow(r, hi)];
#pragma unroll
    for (int r = 0; r < 16; ++r) {
        const size_t row = (size_t)b * SEQ + qw0 + crow(r, hi);
        float ss = 0.f;
#pragma unroll
        for (int db = 0; db < 4; ++db) { const float v = o[db][r] * f[r]; O[row * D + 512 + h * 128 + 32 * db + r32] = (bf16_t)f2bf(v); ss += v * v; }
        ss += __shfl_xor(ss, 1); ss += __shfl_xor(ss, 2); ss += __shfl_xor(ss, 4); ss += __shfl_xor(ss, 8); ss += __shfl_xor(ss, 16);
        if (r32 == 0) SS[row * 16 + 8 + h] = ss;
    }
}
}

struct Args { const float* in[21]; float* out; unsigned char* ws; int ph_lo, ph_hi; };

struct Frame {
    LAS unsigned char* lds;
    int wave, G, bid;
    const float *x, *c, *w_ada, *b_ada, *norm_attn, *norm_ffn, *w_in, *q_a_norm, *w_q_up, *kv_a_norm, *w_kv_up, *q_norm, *k_nope_norm, *k_rope_norm,
        *out_norm_sb, *out_norm_mla, *w_out, *w_gate, *w_up, *w_down;
    const int* pos;
    float* out;
    float* mod;
    bf16_t *Win_t, *Wq_t, *Wkv_t, *Wout_t, *Wgu_t, *Wd_t;
    float* SS;
    bf16_t *H, *PROJ, *QM, *KM, *VM, *O, *A2;
    float *COS, *SIN;
};

__device__ __forceinline__ void transpose_item(const float* W, int K, int N, bf16_t* WT, LAS float* scr, int item, int lane, int mode, const float* g0, const float* g1) {
    const int nblk = N / 32, kb = item / nblk, nb = item % nblk, k0 = 64 * kb, n0 = 32 * nb;
    const float nsc = (mode == 0 && n0 < 512) ? 0.18033688011112042f : 1.f;
#pragma unroll 8
    for (int i = 0; i < 32; ++i) {
        const int kk = 2 * i + (lane >> 5), k = k0 + kk;
        float gk = 1.f;
        if (mode == 1 || mode == 2) gk = g0[k];
        if (mode == 3) gk = (k < 512) ? g0[k] : g1[k - 512];
        scr[kk * 33 + (lane & 31)] = __builtin_nontemporal_load(W + (size_t)k * N + n0 + (lane & 31)) * gk * nsc;
    }
    asm volatile("s_waitcnt lgkmcnt(0)" ::: "memory");
    const int c = lane & 7;
#pragma unroll
    for (int j = 0; j < 4; ++j) {
        const int nn = (lane >> 3) + 8 * j, n = n0 + nn;
        int row = n;
        if (mode == 1) row = (n / 192) * 256 + (n % 192);
        if (mode == 4) row = (n / 128) * 256 + (n % 128);
        if (mode == 5) row = (n / 128) * 256 + (n % 128) + 128;
        const LAS float* s = scr + (8 * c) * 33 + nn;
        v4u o; o.x = pk2(s[0 * 33], s[1 * 33]); o.y = pk2(s[2 * 33], s[3 * 33]); o.z = pk2(s[4 * 33], s[5 * 33]); o.w = pk2(s[6 * 33], s[7 * 33]);
        *(v4u*)(WT + (size_t)row * K + k0 + 8 * c) = o;
    }
    asm volatile("s_waitcnt lgkmcnt(0)" ::: "memory");
}

__device__ __forceinline__ void p0_prep(Frame& F) {
    LAS float* sc = (LAS float*)F.lds;
    LAS float* red = (LAS float*)(F.lds + 32768);
    if (F.bid < 192) {
        for (int i = tid_now(); i < 8 * 1024; i += NT) sc[i] = siluf(F.c[i]);
        __syncthreads();
        for (int it = F.bid; it < 192; it += F.G) {
            const int tid = tid_now(), cq = tid & 7, kg = tid >> 3, n0 = it * 32 + 4 * cq;
            f32x4 w4[16];
#pragma unroll
            for (int kk = 0; kk < 16; ++kk) w4[kk] = __builtin_nontemporal_load((const f32x4*)(F.w_ada + (size_t)(kg * 16 + kk) * 6144 + n0));
            f32x4 acc[8];
#pragma unroll
            for (int b = 0; b < 8; ++b) acc[b] = (f32x4){0.f, 0.f, 0.f, 0.f};
#pragma unroll
            for (int kk = 0; kk < 16; ++kk)
#pragma unroll
                for (int b = 0; b < 8; ++b) acc[b] += w4[kk] * sc[b * 1024 + kg * 16 + kk];
#pragma unroll
            for (int b = 0; b < 8; ++b) *(LAS f32x4*)(red + (kg * 8 + b) * 32 + 4 * cq) = acc[b];
            __syncthreads();
            if (tid < 256) {
                const int b = tid >> 5, j = tid & 31, n = it * 32 + j;
                float s = F.b_ada[n];
#pragma unroll 8
                for (int g = 0; g < 64; ++g) s += red[(g * 8 + b) * 32 + j];
                F.mod[b * 6144 + n] = s;
            }
            __syncthreads();
        }
    }
    __syncthreads();
    LAS float* scr = (LAS float*)(F.lds + F.wave * 16384);
    const int gw = F.bid * NW + F.wave, NGW = F.G * NW;
    constexpr int I_IN = (D / 64) * (NPROJ_REAL / 32), I_Q = (QRANK / 64) * (768 / 32), I_KV = (KVRANK / 64) * (1024 / 32), I_O = (D / 64) * (D / 32),
                  I_G = (D / 64) * (FF / 32), I_D = (FF / 64) * (D / 32);
    (void)I_Q; (void)I_KV; (void)I_O;
    {
        const bool split = false;
        const int first = split ? 192 : 0, nb = F.G - first;
        if (F.bid >= first) {
            const int gw2 = (F.bid - first) * NW + F.wave, NGW2 = nb * NW;
            for (int it = gw2; it < I_IN; it += NGW2) transpose_item(F.w_in, D, NPROJ_REAL, F.Win_t, scr, it, lane_now(), 0, nullptr, nullptr);
        }
    }
    {
        const int gt = F.bid * NT + tid_now(), NGT = F.G * NT;
        const v4u z = (v4u){0u, 0u, 0u, 0u};
        for (int i = gt; i < 64 * 1024 / 8; i += NGT) *(v4u*)(F.Win_t + (size_t)NPROJ_REAL * D + (size_t)i * 8) = z;
        for (int i = gt; i < 4 * 64 * 384 / 8; i += NGT) {
            const int h = i / (64 * 384 / 8), r = i % (64 * 384 / 8);
            *(v4u*)(F.Wq_t + (size_t)(h * 256 + 192) * QRANK + (size_t)r * 8) = z;
        }
    }
}


__device__ __forceinline__ void p2_tail_ffn_weights(Frame& F) {
    const int first = (F.G > 64) ? 64 : 0, nb = F.G - first;
    if (F.bid < first) return;
    LAS float* scr = (LAS float*)(F.lds + F.wave * 16384);
    const int gw = (F.bid - first) * NW + F.wave, NGW = nb * NW;
    constexpr int I_G = (D / 64) * (FF / 32), I_D = (FF / 64) * (D / 32), I_Q = (QRANK / 64) * (768 / 32), I_KV = (KVRANK / 64) * (1024 / 32), I_O = (D / 64) * (D / 32);
    for (int it = gw; it < I_Q + I_KV + I_O + 2 * I_G + I_D; it += NGW) {
        int r = it;
        if (r < I_Q) { transpose_item(F.w_q_up, QRANK, 768, F.Wq_t, scr, r, lane_now(), 1, F.q_a_norm, nullptr); continue; } r -= I_Q;
        if (r < I_KV) { transpose_item(F.w_kv_up, KVRANK, 1024, F.Wkv_t, scr, r, lane_now(), 2, F.kv_a_norm, nullptr); continue; } r -= I_KV;
        if (r < I_O) { transpose_item(F.w_out, D, D, F.Wout_t, scr, r, lane_now(), 3, F.out_norm_sb, F.out_norm_mla); continue; } r -= I_O;
        if (r < I_G) { transpose_item(F.w_gate, D, FF, F.Wgu_t, scr, r, lane_now(), 4, nullptr, nullptr); continue; } r -= I_G;
        if (r < I_G) { transpose_item(F.w_up, D, FF, F.Wgu_t, scr, r, lane_now(), 5, nullptr, nullptr); continue; } r -= I_G;
        transpose_item(F.w_down, FF, D, F.Wd_t, scr, r, lane_now(), 6, nullptr, nullptr);
    }
}

__device__ __forceinline__ void p_hnorm(Frame& F, const float* X, const float* g, int ishift, int iscale, bf16_t* Hout) {
    const int vb = (F.G % 8 == 0) ? (F.bid % 8) * (F.G / 8) + F.bid / 8 : F.bid;
    const int gw = vb * NW + F.wave, NGW = F.G * NW, lane = lane_now();
    for (int m0 = gw * 8; m0 < M; m0 += NGW * 8) {
        const int b = m0 / SEQ;
        const float* mb = F.mod + (size_t)b * 6144;
        f32x4 mul[4], add[4];
#pragma unroll
        for (int j = 0; j < 4; ++j) {
            const int col = 4 * lane + 256 * j;
            mul[j] = *(const f32x4*)(g + col) * (*(const f32x4*)(mb + iscale * 1024 + col) + 1.f);
            add[j] = *(const f32x4*)(mb + ishift * 1024 + col);
        }
#pragma unroll 2
        for (int i = 0; i < 8; ++i) {
            const int m = m0 + i;
            const f32x4* xr = (const f32x4*)(X + (size_t)m * D) + lane;
            f32x4 v[4]; float s = 0.f;
#pragma unroll
            for (int j = 0; j < 4; ++j) { v[j] = __builtin_nontemporal_load(xr + 64 * j); s += (v[j].x * v[j].x + v[j].y * v[j].y) + (v[j].z * v[j].z + v[j].w * v[j].w); }
            const float rstd = rsqrtf(wave_sum(s) * (1.f / D) + EPS);
            unsigned long long* o8 = (unsigned long long*)(Hout + (size_t)m * D) + lane;
#pragma unroll
            for (int j = 0; j < 4; ++j) {
                const f32x4 h = v[j] * rstd * mul[j] + add[j];
                o8[64 * j] = (unsigned long long)pk2(h.x, h.y) | ((unsigned long long)pk2(h.z, h.w) << 32);
            }
        }
    }
}

template <bool DUAL, class Epi>
__device__ __forceinline__ void ngemm(Frame& F, const bf16_t* A, int lda, const bf16_t* Bt, int K, int N, const Epi& epi) {
    const long total = (long)(M / 4) * N;
    for (long idx = (long)F.bid * NT + tid_now(); idx < total; idx += (long)F.G * NT) {
        const int n = (int)(idx % N), m0 = (int)(idx / N) * 4;
        const int r0 = DUAL ? (n / 128) * 256 + (n % 128) : n;
        const v4u* b0 = (const v4u*)(Bt + (size_t)r0 * K);
        const v4u* b1 = (const v4u*)(Bt + (size_t)(r0 + 128) * K);
        const v4u* a0 = (const v4u*)(A + (size_t)m0 * lda);
        float acc0 = 0.f, acc1 = 0.f, acc2 = 0.f, acc3 = 0.f, bcc0 = 0.f, bcc1 = 0.f, bcc2 = 0.f, bcc3 = 0.f;
        for (int k8 = 0; k8 < K / 8; ++k8) {
            const v4u bv = b0[k8];
            const v4u av0 = a0[k8], av1 = a0[k8 + lda / 8], av2 = a0[k8 + 2 * (lda / 8)], av3 = a0[k8 + 3 * (lda / 8)];
            acc0 += dot8(av0, bv); acc1 += dot8(av1, bv); acc2 += dot8(av2, bv); acc3 += dot8(av3, bv);
            if (DUAL) { const v4u bw = b1[k8]; bcc0 += dot8(av0, bw); bcc1 += dot8(av1, bw); bcc2 += dot8(av2, bw); bcc3 += dot8(av3, bw); }
        }
        epi(m0, n, acc0, bcc0); epi(m0 + 1, n, acc1, bcc1); epi(m0 + 2, n, acc2, bcc2); epi(m0 + 3, n, acc3, bcc3);
    }
}
struct NEpiBf16 { bf16_t* O; int ldc; __device__ __forceinline__ void operator()(int m, int n, float a, float) const { O[(size_t)m * ldc + n] = (bf16_t)f2bf(a); } };
struct NEpiF32 { float* O; int ldc; __device__ __forceinline__ void operator()(int m, int n, float a, float) const { O[(size_t)m * ldc + n] = a; } };
struct NEpiRes { const float* base; float* out; const float* mod; int igate;
    __device__ __forceinline__ void operator()(int m, int n, float a, float) const { const int b = m / SEQ; out[(size_t)m * D + n] = base[(size_t)m * D + n] + mod[b * 6144 + igate * 1024 + n] * a; } };
struct NEpiSwiglu { bf16_t* O; __device__ __forceinline__ void operator()(int m, int n, float g, float u) const { O[(size_t)m * FF + n] = (bf16_t)f2bf(siluf(g) * u); } };

__device__ __forceinline__ void rope_freq_cs(int i, int pos, float& cs, float& sn) {
    const float freq = 1.0f / powf(10000.0f, (float)i * (1.0f / 32.0f));
    const float ang = (float)pos * freq;
    sincosf(ang, &sn, &cs);
}
__device__ __forceinline__ void p_qpost(Frame& F, const float* tmp) {
    const int gw = F.bid * NW + F.wave, NGW = F.G * NW, lane = lane_now();
    for (int m = gw; m < M; m += NGW) {
        const bf16_t* pr = F.PROJ + (size_t)m * NPROJ + C_CQ;
        float s = 0.f;
#pragma unroll
        for (int i = 0; i < 6; ++i) { const float v = bf2f(pr[lane + 64 * i]); s += v * v; }
        const float rstd_cq = rsqrtf(wave_sum(s) * (1.f / QRANK) + EPS);
        const int pos = F.pos[m];
        float cs, sn; rope_freq_cs(lane & 31, pos, cs, sn);
#pragma unroll
        for (int h = 0; h < 4; ++h) {
            float q[3]; float ss = 0.f;
#pragma unroll
            for (int i = 0; i < 3; ++i) { q[i] = tmp[(size_t)m * 1024 + h * 256 + lane + 64 * i] * rstd_cq; ss += q[i] * q[i]; }
            const float rstd = rsqrtf(wave_sum(ss) * (1.f / MQK) + EPS);
#pragma unroll
            for (int i = 0; i < 3; ++i) q[i] = q[i] * rstd * F.q_norm[lane + 64 * i];
            const float partner = __shfl_xor(q[2], 32);
            q[2] = (lane < 32) ? (q[2] * cs - partner * sn) : (q[2] * cs + partner * sn);
            const float qs = 0.10411754714f;
#pragma unroll
            for (int i = 0; i < 3; ++i) F.QM[((size_t)m * 4 + h) * MQK + lane + 64 * i] = (bf16_t)f2bf(q[i] * qs);
        }
    }
}
__device__ __forceinline__ void p_kvpost(Frame& F, const float* tmp) {
    const int gw = F.bid * NW + F.wave, NGW = F.G * NW, lane = lane_now();
    for (int m = gw; m < M; m += NGW) {
        const bf16_t* pr = F.PROJ + (size_t)m * NPROJ;
        float s = 0.f;
#pragma unroll
        for (int i = 0; i < 4; ++i) { const float v = bf2f(pr[C_CKV + lane + 64 * i]); s += v * v; }
        const float rstd_ckv = rsqrtf(wave_sum(s) * (1.f / KVRANK) + EPS);
        const int pos = F.pos[m];
        float cs, sn; rope_freq_cs(lane & 31, pos, cs, sn);
        float kr = bf2f(pr[C_KR + lane]);
        const float rstd_kr = rsqrtf(wave_sum(kr * kr) * (1.f / MROPE) + EPS);
        kr = kr * rstd_kr * F.k_rope_norm[lane];
        const float partner = __shfl_xor(kr, 32);
        kr = (lane < 32) ? (kr * cs - partner * sn) : (kr * cs + partner * sn);
#pragma unroll
        for (int h = 0; h < 4; ++h) {
            float k[2], v[2]; float ss = 0.f;
#pragma unroll
            for (int i = 0; i < 2; ++i) { k[i] = tmp[(size_t)m * 1024 + h * 256 + lane + 64 * i] * rstd_ckv; ss += k[i] * k[i]; v[i] = tmp[(size_t)m * 1024 + h * 256 + 128 + lane + 64 * i] * rstd_ckv; }
            const float rstd = rsqrtf(wave_sum(ss) * (1.f / MNOPE) + EPS);
#pragma unroll
            for (int i = 0; i < 2; ++i) {
                F.KM[((size_t)m * 4 + h) * MQK + lane + 64 * i] = (bf16_t)f2bf(k[i] * rstd * F.k_nope_norm[lane + 64 * i]);
                F.VM[((size_t)m * 4 + h) * MV + lane + 64 * i] = (bf16_t)f2bf(v[i]);
            }
            F.KM[((size_t)m * 4 + h) * MQK + 128 + lane] = (bf16_t)f2bf(kr);
        }
    }
}


__device__ __forceinline__ void p_rope_table(Frame& F, int first_block, int nblocks) {
    if (F.bid < first_block || nblocks <= 0) return;
    const int gt = (F.bid - first_block) * NT + tid_now(), NGT = nblocks * NT;
    for (int idx = gt; idx < M * 32; idx += NGT) { float cs, sn; rope_freq_cs(idx & 31, F.pos[idx >> 5], cs, sn); F.COS[idx] = cs; F.SIN[idx] = sn; }
}
__device__ __forceinline__ float ssq8(v4u a) {
    float s = 0.f;
    { const float lo = bf2f(a.x & 0xffffu), hi = __uint_as_float(a.x & 0xffff0000u); s += lo * lo + hi * hi; }
    { const float lo = bf2f(a.y & 0xffffu), hi = __uint_as_float(a.y & 0xffff0000u); s += lo * lo + hi * hi; }
    { const float lo = bf2f(a.z & 0xffffu), hi = __uint_as_float(a.z & 0xffff0000u); s += lo * lo + hi * hi; }
    { const float lo = bf2f(a.w & 0xffffu), hi = __uint_as_float(a.w & 0xffff0000u); s += lo * lo + hi * hi; }
    return s;
}
__device__ __forceinline__ void p3_stats(Frame& F, int pm, int pn) {
    LAS float* st = (LAS float*)(F.lds + pg8::ST_OFF);
    const int lane = lane_now(), l8 = lane & 7;
    f32x4 gk[2];
    gk[0] = *(const f32x4*)(F.k_rope_norm + 8 * l8); gk[1] = *(const f32x4*)(F.k_rope_norm + 8 * l8 + 4);
#pragma unroll 2
    for (int p = 0; p < 4; ++p) {
        const int r = F.wave * 32 + p * 8 + (lane >> 3); const size_t row = (size_t)pm * 256 + r;
        const bf16_t* pr = F.PROJ + row * NPROJ + C_CQ + l8 * 8;
        v4u v[11];
#pragma unroll
        for (int i = 0; i < 11; ++i) v[i] = *(const v4u*)(pr + 64 * i);
        const int i0 = (8 * l8) & 31;
        const f32x4 cs0 = *(const f32x4*)(F.COS + row * 32 + i0), cs1 = *(const f32x4*)(F.COS + row * 32 + i0 + 4);
        const f32x4 sn0 = *(const f32x4*)(F.SIN + row * 32 + i0), sn1 = *(const f32x4*)(F.SIN + row * 32 + i0 + 4);
        float s_cq = 0.f, s_ckv = 0.f;
#pragma unroll
        for (int i = 0; i < 6; ++i) s_cq += ssq8(v[i]);
#pragma unroll
        for (int i = 6; i < 10; ++i) s_ckv += ssq8(v[i]);
        float s_kr = ssq8(v[10]);
        s_cq += __shfl_xor(s_cq, 1); s_ckv += __shfl_xor(s_ckv, 1); s_kr += __shfl_xor(s_kr, 1);
        s_cq += __shfl_xor(s_cq, 2); s_ckv += __shfl_xor(s_ckv, 2); s_kr += __shfl_xor(s_kr, 2);
        s_cq += __shfl_xor(s_cq, 4); s_ckv += __shfl_xor(s_ckv, 4); s_kr += __shfl_xor(s_kr, 4);
        if (l8 == 0) { st[r] = rsqrtf(s_cq * (1.f / QRANK) + EPS); st[256 + r] = rsqrtf(s_ckv * (1.f / KVRANK) + EPS); }
        const float rk = rsqrtf(s_kr * (1.f / MROPE) + EPS);
        const v4u b = v[10];
        float x[8];
        x[0] = bf2f(b.x & 0xffffu) * rk * gk[0][0]; x[1] = __uint_as_float(b.x & 0xffff0000u) * rk * gk[0][1];
        x[2] = bf2f(b.y & 0xffffu) * rk * gk[0][2]; x[3] = __uint_as_float(b.y & 0xffff0000u) * rk * gk[0][3];
        x[4] = bf2f(b.z & 0xffffu) * rk * gk[1][0]; x[5] = __uint_as_float(b.z & 0xffff0000u) * rk * gk[1][1];
        x[6] = bf2f(b.w & 0xffffu) * rk * gk[1][2]; x[7] = __uint_as_float(b.w & 0xffff0000u) * rk * gk[1][3];
        float y[8];
#pragma unroll
        for (int e = 0; e < 8; ++e) { const float part = __shfl_xor(x[e], 4); const float cs = (e < 4) ? cs0[e & 3] : cs1[e & 3], sn = (e < 4) ? sn0[e & 3] : sn1[e & 3];
            y[e] = (l8 < 4) ? (x[e] * cs - part * sn) : (x[e] * cs + part * sn); }
        v4u w; w.x = pk2(y[0], y[1]); w.y = pk2(y[2], y[3]); w.z = pk2(y[4], y[5]); w.w = pk2(y[6], y[7]);
        *(v4u*)(F.KM + (row * 4 + pn) * MQK + MNOPE + 8 * l8) = w;
    }
}
__device__ __forceinline__ void p3_mla_up(Frame& F) {
    const int v = (F.G % 8 == 0) ? (F.bid % 8) * (F.G / 8) + F.bid / 8 : F.bid;
    if (v < 256) {
        const int pm = v >> 2, pn = v & 3;
        __syncthreads();
        p3_stats(F, pm, pn);
        __syncthreads();
        const pg8::OneUnit S{pm, pn};
        { pg8::Gemm g{F.PROJ + C_CQ, F.Wq_t, M, 1024, QRANK, NPROJ};
          pg8::gemm_phase<pg8::EpiQ, pg8::OneUnit, false>(F.lds, g, S, pg8::EpiQ{F.QM, F.q_norm, F.COS, F.SIN}); }
        { pg8::Gemm g{F.PROJ + C_CKV, F.Wkv_t, M, 1024, KVRANK, NPROJ};
          pg8::gemm_phase<pg8::EpiKV, pg8::OneUnit, false>(F.lds, g, S, pg8::EpiKV{F.KM, F.VM, F.k_nope_norm}); }
    }
}

__device__ __forceinline__ void p_attn_naive(Frame& F) {
    const int gw = F.bid * NW + F.wave, NGW = F.G * NW, lane = lane_now();
    for (int it = gw; it < BATCH * SBH * SEQ; it += NGW) {
        const int t = it % SEQ, h = (it / SEQ) % SBH, b = it / (SEQ * SBH);
        const size_t row = (size_t)b * SEQ + t;
        const float q = bf2f(F.PROJ[row * NPROJ + h * 64 + lane]);
        float accl = 0.f, o = 0.f;
        for (int s = t - 1; s >= 0; --s) {
            const bf16_t* kr = F.PROJ + ((size_t)b * SEQ + s) * NPROJ + h * 64 + lane;
            const float z = wave_sum(q * bf2f(kr[512])) * 0.6931471805599453f;
            const float lb = logsig(z);
            const float w = expf(lb + accl);
            o += w * bf2f(kr[1024]);
            accl += lb - z;
        }
        F.O[row * D + h * 64 + lane] = (bf16_t)f2bf(o);
        const float ss = wave_sum(o * o);
        if (lane == 0) F.SS[row * 16 + h] = ss;
    }
    for (int it = gw; it < BATCH * MH * SEQ; it += NGW) {
        const int t = it % SEQ, h = (it / SEQ) % MH, b = it / (SEQ * MH);
        const size_t row = (size_t)b * SEQ + t;
        float q[3];
#pragma unroll
        for (int i = 0; i < 3; ++i) q[i] = bf2f(F.QM[(row * 4 + h) * MQK + lane + 64 * i]);
        float mx = -INFINITY, l = 0.f, o0 = 0.f, o1 = 0.f;
        for (int s = 0; s <= t; ++s) {
            const size_t kr = ((size_t)b * SEQ + s) * 4 + h;
            float d = 0.f;
#pragma unroll
            for (int i = 0; i < 3; ++i) d += q[i] * bf2f(F.KM[kr * MQK + lane + 64 * i]);
            const float z = wave_sum(d);
            const float mn = fmaxf(mx, z), corr = exp2f(mx - mn), p = exp2f(z - mn);
            l = l * corr + p;
            o0 = o0 * corr + p * bf2f(F.VM[kr * MV + lane]);
            o1 = o1 * corr + p * bf2f(F.VM[kr * MV + 64 + lane]);
            mx = mn;
        }
        o0 /= l; o1 /= l;
        F.O[row * D + 512 + h * 128 + lane] = (bf16_t)f2bf(o0);
        F.O[row * D + 512 + h * 128 + 64 + lane] = (bf16_t)f2bf(o1);
        const float ss = wave_sum(o0 * o0 + o1 * o1);
        if (lane == 0) F.SS[row * 16 + 8 + h] = ss;
    }
}

__device__ __forceinline__ void p_attn_mla(Frame& F, unsigned* qctr) {
    LAS unsigned* slot = (LAS unsigned*)(F.lds + att::SLOT_OFF);
    if (F.G == 256) {
        const int x = F.bid & 7, idx = F.bid >> 3, bh = 4 * x + (idx >> 3), qb = 7 - (idx & 7);
        __syncthreads();
        att::mla_unit(F.lds, F.QM, F.KM, F.VM, F.O, F.SS, bh >> 2, bh & 3, qb);
        return;
    }
    for (;;) {
        __syncthreads();
        if (tid_now() == 0) *slot = atomicAdd(qctr, 1u);
        __syncthreads();
        const unsigned u = *slot;
        if (u >= 256u) break;
        const int r = (int)u & 31, qb = 7 - ((int)u >> 5);
        att::mla_unit(F.lds, F.QM, F.KM, F.VM, F.O, F.SS, r >> 2, r & 3, qb);
    }
}
__device__ __forceinline__ void p_attn_sb(Frame& F, unsigned* qctr) {
    LAS unsigned* slot = (LAS unsigned*)(F.lds + att::SLOT_OFF);
    const bool xl = (F.G == 256);
    const int x = F.bid & 7;
    unsigned* ctr = xl ? qctr + 64 * (1 + x) : qctr;
    const unsigned nunits = xl ? 64u : 512u;
    for (;;) {
        __syncthreads();
        if (tid_now() == 0) *slot = atomicAdd(ctr, 1u);
        __syncthreads();
        const unsigned u = *slot;
        if (u >= nunits) break;
        int bh, qb;
        if (xl) { bh = 8 * x + ((int)u & 7); qb = 7 - ((int)u >> 3); } else { bh = (int)u & 63; qb = 7 - ((int)u >> 6); }
        att::sb_unit(F.lds, F.PROJ, F.O, F.SS, bh >> 3, bh & 7, qb);
    }
}
__device__ __forceinline__ void p_mixnorm(Frame& F, bf16_t* Hout) {
    const int gw = F.bid * NW + F.wave, NGW = F.G * NW, lane = lane_now();
    for (int m = gw; m < M; m += NGW) {
        float s0 = 0.f, s1 = 0.f;
#pragma unroll
        for (int h = 0; h < 8; ++h) s0 += F.SS[(size_t)m * 16 + h];
#pragma unroll
        for (int h = 0; h < 4; ++h) s1 += F.SS[(size_t)m * 16 + 8 + h];
        const float r0 = rsqrtf(s0 * (1.f / 512) + EPS), r1 = rsqrtf(s1 * (1.f / 512) + EPS);
#pragma unroll
        for (int i = 0; i < 16; ++i) {
            const int col = lane + 64 * i;
            Hout[(size_t)m * D + col] = (bf16_t)f2bf(bf2f(F.O[(size_t)m * D + col]) * (col < 512 ? r0 : r1));
        }
    }
}


#define XB_TMO      128
#define XB_XCNT(j)  (256  + 64 * (j))
#define XB_XSUB(j)  (1280 + 64 * (j))
#define XB_XGEN(j)  (2304 + 64 * (j))
#define XB_TOP      3328
#define XB_TOPGEN   3392
#define XCD_BAR_WORDS 3456
#define XB_SPIN_CAP (1u << 18)
__device__ __forceinline__ unsigned xb_ld(unsigned* p)              { return __hip_atomic_load(p, __ATOMIC_RELAXED, __HIP_MEMORY_SCOPE_AGENT); }
__device__ __forceinline__ unsigned xb_add(unsigned* p, unsigned v) { return __hip_atomic_fetch_add(p, v, __ATOMIC_RELAXED, __HIP_MEMORY_SCOPE_AGENT); }
__device__ __forceinline__ unsigned xb_xcc_id() { return (unsigned)__builtin_amdgcn_s_getreg((3 << 11) | 20) & 0xFu; }
#define XB_SPIN(cond, bar) do { unsigned _sp = 0; while (cond) { __builtin_amdgcn_s_sleep(1); \
    if ((++_sp & 255u) == 0u) { if (xb_ld(&(bar)[XB_TMO])) break; if (_sp > XB_SPIN_CAP) { atomicAdd(&(bar)[XB_TMO], 1u); break; } } } } while (0)
struct XcdBarrier { unsigned* bar; unsigned x; volatile LAS unsigned* st; };
__device__ __forceinline__ XcdBarrier xcd_barrier_post(unsigned* bar, volatile LAS unsigned* st) {
    XcdBarrier b; b.bar = bar; b.x = xb_xcc_id(); b.st = st;
    if (threadIdx.x == 0) (void)xb_add(&bar[XB_XCNT(b.x)], 1u);
    return b;
}
__device__ __forceinline__ void xcd_barrier_complete(unsigned* bar, unsigned x, unsigned& nloc, unsigned& nx) {
    const unsigned G = gridDim.x * gridDim.y * gridDim.z;
    unsigned sum, cnt, mine, sp = 0u;
    for (;;) {
        sum = 0u; cnt = 0u; mine = 0u;
#pragma unroll
        for (unsigned j = 0; j < 16; ++j) { const unsigned c = xb_ld(&bar[XB_XCNT(j)]); sum += c; cnt += (c > 0u) ? 1u : 0u; mine = (j == x) ? c : mine; }
        if (sum == G) break;
        __builtin_amdgcn_s_sleep(1);
        if ((++sp & 255u) == 0u) { if (xb_ld(&bar[XB_TMO])) break; if (sp > XB_SPIN_CAP) { atomicAdd(&bar[XB_TMO], 1u); break; } }
    }
    nloc = mine > 0u ? mine : 1u; nx = cnt > 0u ? cnt : 1u;
}
__device__ __forceinline__ void xcd_barrier(const XcdBarrier& b) {
    asm volatile("s_waitcnt vmcnt(0)" ::: "memory");
    __syncthreads();
    if (threadIdx.x == 0) {
        unsigned* bar = b.bar;
        __builtin_amdgcn_s_waitcnt(0);
        unsigned nloc = b.st[0], nx = b.st[1];
        if (nloc == 0u) { xcd_barrier_complete(bar, b.x, nloc, nx); b.st[0] = nloc; b.st[1] = nx; }
        const unsigned old = xb_add(&bar[XB_XSUB(b.x)], 1u);
        const unsigned gen = old / nloc;
        if (old + 1u == (gen + 1u) * nloc) {
            __builtin_amdgcn_fence(__ATOMIC_RELEASE, "agent");
            asm volatile("s_waitcnt vmcnt(0)" ::: "memory");
            const unsigned og = xb_add(&bar[XB_TOP], 1u);
            const unsigned tg = og / nx;
            if (og + 1u == (tg + 1u) * nx) xb_add(&bar[XB_TOPGEN], 1u);
            else XB_SPIN(xb_ld(&bar[XB_TOPGEN]) == tg, bar);
            __builtin_amdgcn_fence(__ATOMIC_ACQUIRE, "agent");
            xb_add(&bar[XB_XGEN(b.x)], 1u);
            asm volatile("s_waitcnt vmcnt(0)" ::: "memory");
        } else {
            XB_SPIN(xb_ld(&bar[XB_XGEN(b.x)]) == gen, bar);
            __builtin_amdgcn_fence(__ATOMIC_ACQUIRE, "agent");
            asm volatile("s_waitcnt vmcnt(0)" ::: "memory");
        }
    }
    __syncthreads();
}

constexpr int NPHASE = 9;
__global__ void __launch_bounds__(NT, 2) mega(Args args) {
    extern __shared__ __attribute__((aligned(16))) unsigned char lds[];
    cg::grid_group grid = cg::this_grid();
    Frame F;
    F.lds = (LAS unsigned char*)lds;
    F.wave = __builtin_amdgcn_readfirstlane((int)threadIdx.x >> 6); F.G = gridDim.x; F.bid = blockIdx.x;
    F.x = args.in[0]; F.c = args.in[1]; F.pos = (const int*)args.in[2]; F.w_ada = args.in[3]; F.b_ada = args.in[4]; F.norm_attn = args.in[5]; F.norm_ffn = args.in[6];
    F.w_in = args.in[7]; F.q_a_norm = args.in[8]; F.w_q_up = args.in[9]; F.kv_a_norm = args.in[10]; F.w_kv_up = args.in[11]; F.q_norm = args.in[12];
    F.k_nope_norm = args.in[13]; F.k_rope_norm = args.in[14]; F.out_norm_sb = args.in[15]; F.out_norm_mla = args.in[16]; F.w_out = args.in[17];
    F.w_gate = args.in[18]; F.w_up = args.in[19]; F.w_down = args.in[20];
    F.out = args.out;
    unsigned char* ws = args.ws;
    F.mod = (float*)(ws + WS_MOD);
    F.Win_t = (bf16_t*)(ws + WS_WIN); F.Wq_t = (bf16_t*)(ws + WS_WQ); F.Wkv_t = (bf16_t*)(ws + WS_WKV); F.Wout_t = (bf16_t*)(ws + WS_WOUT);
    F.Wgu_t = (bf16_t*)(ws + WS_WGU); F.Wd_t = (bf16_t*)(ws + WS_WD);
    F.SS = (float*)(ws + WS_SS); F.H = (bf16_t*)(ws + WS_H); F.PROJ = (bf16_t*)(ws + WS_PROJ); F.QM = (bf16_t*)(ws + WS_QM); F.KM = (bf16_t*)(ws + WS_KM);
    F.VM = (bf16_t*)(ws + WS_VM); F.O = (bf16_t*)(ws + WS_O); F.A2 = (bf16_t*)(ws + WS_A2);
    F.COS = (float*)(ws + WS_COS); F.SIN = (float*)(ws + WS_SIN);

    const int lo = args.ph_lo, hi = args.ph_hi;
#define IN(k) (lo <= (k) && (k) < hi)
    volatile LAS unsigned* MISC = (volatile LAS unsigned*)(F.lds + MISC_OFF);
    if (tid_now() < 16) MISC[tid_now()] = 0u;
    __syncthreads();
    const XcdBarrier bar = xcd_barrier_post((unsigned*)(ws + WS_CTL), MISC + 8);
    if (lo < 0) grid.sync();
#define SEAM(k) do { if ((k) + 1 < hi) xcd_barrier(bar); } while (0)
    if (IN(0)) { p0_prep(F); SEAM(0); }
    if (IN(1)) { p_hnorm(F, F.x, F.norm_attn, 0, 1, F.H); SEAM(1); }
    if (IN(2)) { pg8::Gemm g{F.H, F.Win_t, M, NPROJ, D, D}; pg8::StaticOrder S; S.init(M, NPROJ, F.G, F.bid); pg8::gemm_phase<pg8::EpiBf16, pg8::StaticOrder, true>(F.lds, g, S, pg8::EpiBf16{F.PROJ, NPROJ}); p2_tail_ffn_weights(F); if (F.G > 64) p_rope_table(F, 64, F.G - 64); else p_rope_table(F, 0, F.G); SEAM(2); }
    if (IN(3)) { p3_mla_up(F); SEAM(3); }
    if (IN(4)) { unsigned* qc = (unsigned*)((unsigned char*)F.mod + WS_QC); p_attn_mla(F, qc); p_attn_sb(F, qc + 64); SEAM(4); }
    if (IN(5)) {
        pg8::Gemm g{F.O, F.Wout_t, M, D, D, D}; pg8::StaticOrder S; S.init(M, D, F.G, F.bid);
        pg8::Unit u0; u0.pm = 0; u0.pn = 0; (void)S.next(0, u0);
        LAS float* tw = (LAS float*)(F.lds + pg8::ST_OFF);
        { const int t = tid_now();
          if (t < 256) { const float* ss = F.SS + (size_t)(u0.pm * 256 + t) * 16;
              const f32x4 a = *(const f32x4*)ss, b = *(const f32x4*)(ss + 4), c = *(const f32x4*)(ss + 8);
              const float ssb = ((a[0] + a[1]) + (a[2] + a[3])) + ((b[0] + b[1]) + (b[2] + b[3])), smla = (c[0] + c[1]) + (c[2] + c[3]);
              tw[t] = sqrtf((smla * (1.f / 512) + EPS) / (ssb * (1.f / 512) + EPS)); tw[256 + t] = rsqrtf(smla * (1.f / 512) + EPS); } }
        __syncthreads();
        pg8::gemm_phase<pg8::EpiResNorm, pg8::StaticOrder, false>(F.lds, g, S, pg8::EpiResNorm{F.x, F.out, F.mod, tw, F.norm_ffn, F.H, (unsigned*)((unsigned char*)F.mod + WS_XBUF), (unsigned*)((unsigned char*)F.mod + WS_PCNT)});
        SEAM(5); }
    if (IN(7)) { pg8::Gemm g{F.H, F.Wgu_t, M, 2 * FF, D, D}; pg8::StaticOrder S; S.init(M, 2 * FF, F.G, F.bid); pg8::gemm_phase<pg8::EpiSwiglu, pg8::StaticOrder, true>(F.lds, g, S, pg8::EpiSwiglu{F.A2, FF}); SEAM(7); }
    if (IN(8)) { pg8::Gemm g{F.A2, F.Wd_t, M, D, FF, FF}; pg8::StaticOrder S; S.init(M, D, F.G, F.bid); pg8::gemm_phase<pg8::EpiRes, pg8::StaticOrder, true, 2>(F.lds, g, S, pg8::EpiRes{F.out, F.out, F.mod + 5 * 1024}); }
#undef IN
#undef SEAM
}

extern "C" void kernel_launch(void* const* d_in, const int* in_sizes, int n_in, void* d_out, int out_size, void* d_ws, size_t ws_size, hipStream_t stream) {
    static int grid = 0;
    if (grid == 0) {
        if (n_in != 21 || out_size != M * D || ws_size < WS_END) { fprintf(stderr, "kernel_launch: unexpected shapes (n_in %d out %d ws %zu)\n", n_in, out_size, ws_size); grid = -1; return; }
        int dev = 0, cus = 0, per_cu = 0;
        hipGetDevice(&dev);
        hipDeviceGetAttribute(&cus, hipDeviceAttributeMultiprocessorCount, dev);
        if (hipFuncSetAttribute((const void*)mega, hipFuncAttributeMaxDynamicSharedMemorySize, LDS_BYTES) != hipSuccess) { fprintf(stderr, "kernel_launch: hipFuncSetAttribute failed\n"); grid = -1; return; }
        if (hipOccupancyMaxActiveBlocksPerMultiprocessor(&per_cu, (const void*)mega, NT, LDS_BYTES) != hipSuccess || per_cu < 1) { fprintf(stderr, "kernel_launch: occupancy query says %d\n", per_cu); per_cu = 1; }
        (void)hipGetLastError();
        if (cus < 256) { fprintf(stderr, "kernel_launch: needs >= 256 CUs (got %d)\n", cus); grid = -1; return; }
        grid = 256;
    }
    if (grid < 0) return;
    if (hipMemsetAsync((char*)d_ws + WS_CTL, 0, CTL_ZERO_BYTES, stream) != hipSuccess) { fprintf(stderr, "kernel_launch: hipMemsetAsync failed\n"); return; }
    Args a{};
    for (int i = 0; i < 21; ++i) a.in[i] = (const float*)d_in[i];
    a.out = (float*)d_out; a.ws = (unsigned char*)d_ws; a.ph_lo = 0; a.ph_hi = NPHASE;
    void* params[] = {&a};
    hipError_t e = hipLaunchCooperativeKernel((const void*)mega, dim3(grid), dim3(NT), params, LDS_BYTES, stream);
    if (e != hipSuccess) fprintf(stderr, "kernel_launch: cooperative launch failed: %s (grid %d)\n", hipGetErrorString(e), grid);
}
```

```cpp
#include <hip/hip_runtime.h>
#include <hip/hip_cooperative_groups.h>
#include <cstdio>
#include <cstdint>
namespace cg = cooperative_groups;

#define LAS __attribute__((address_space(3)))
typedef unsigned short bf16_t;
typedef unsigned v4u __attribute__((ext_vector_type(4)));
typedef float f32x4 __attribute__((ext_vector_type(4)));

constexpr int BATCH = 8, SEQ = 2048, D = 1024, M = BATCH * SEQ;
constexpr int SBH = 8, SBD = 64, SBW = 512;
constexpr int MH = 4, MNOPE = 128, MROPE = 64, MQK = 192, MV = 128, QRANK = 384, KVRANK = 256;
constexpr int NPROJ_REAL = 2240, NPROJ = 2304;
constexpr int C_CQ = 1536, C_CKV = 1920, C_KR = 2176;
constexpr int FF = 2816;
constexpr float EPS = 1e-6f;
constexpr int NW = 8, NT = NW * 64;

constexpr size_t MiB = 1u << 20;
constexpr size_t WS_MOD = 0, WS_WIN = 1 * MiB, WS_WQ = 6 * MiB, WS_WKV = 7 * MiB, WS_WOUT = 8 * MiB, WS_WGU = 10 * MiB, WS_WD = 21 * MiB;
constexpr size_t WS_SS = 27 * MiB, WS_H = 28 * MiB, WS_PROJ = 60 * MiB, WS_QM = 132 * MiB, WS_KM = 156 * MiB, WS_VM = 180 * MiB, WS_O = 196 * MiB;
constexpr size_t WS_A2 = 60 * MiB, WS_COS = 228 * MiB, WS_SIN = 230 * MiB, WS_END = 232 * MiB;
constexpr int LDS_BYTES = 147456, MISC_OFF = 135168;
constexpr size_t WS_CTL = 256 * 1024, WS_QC = WS_CTL + 16 * 1024, WS_PCNT = WS_CTL + 24 * 1024, CTL_ZERO_BYTES = 40 * 1024, WS_XBUF = 512 * 1024;

__device__ __forceinline__ float bf2f(unsigned v) { return __uint_as_float(v << 16); }
__device__ __forceinline__ unsigned f2bf(float f) { unsigned u = __float_as_uint(f); return (u + 0x7fffu + ((u >> 16) & 1u)) >> 16; }
__device__ __forceinline__ unsigned pk2(float lo, float hi) { return f2bf(lo) | (f2bf(hi) << 16); }
__device__ __forceinline__ float wave_sum(float v) {
#pragma unroll
    for (int o = 1; o < 64; o <<= 1) v += __shfl_xor(v, o);
    return v;
}
__device__ __forceinline__ float wave_max(float v) {
#pragma unroll
    for (int o = 1; o < 64; o <<= 1) v = fmaxf(v, __shfl_xor(v, o));
    return v;
}
__device__ __forceinline__ float siluf(float v) { return v / (1.f + expf(-v)); }
__device__ __forceinline__ float logsig(float z) { return fminf(z, 0.f) - log1pf(expf(-fabsf(z))); }
__device__ __forceinline__ float dot8(v4u a, v4u b) {
    float s = 0.f;
    s += bf2f(a.x & 0xffffu) * bf2f(b.x & 0xffffu); s += __uint_as_float(a.x & 0xffff0000u) * __uint_as_float(b.x & 0xffff0000u);
    s += bf2f(a.y & 0xffffu) * bf2f(b.y & 0xffffu); s += __uint_as_float(a.y & 0xffff0000u) * __uint_as_float(b.y & 0xffff0000u);
    s += bf2f(a.z & 0xffffu) * bf2f(b.z & 0xffffu); s += __uint_as_float(a.z & 0xffff0000u) * __uint_as_float(b.z & 0xffff0000u);
    s += bf2f(a.w & 0xffffu) * bf2f(b.w & 0xffffu); s += __uint_as_float(a.w & 0xffff0000u) * __uint_as_float(b.w & 0xffff0000u);
    return s;
}


__device__ __forceinline__ int tid_now() { int t = threadIdx.x; asm volatile("" : "+v"(t)); return t; }
__device__ __forceinline__ int lane_now() { return tid_now() & 63; }

namespace pg8 {
#define PG8_LAS __attribute__((address_space(3)))
typedef short bf16x8 __attribute__((ext_vector_type(8)));
typedef unsigned u32x4 __attribute__((ext_vector_type(4)));
typedef float f32x2 __attribute__((ext_vector_type(2)));
constexpr int BM = 256, BK = 64, HALF = 128, HTB = HALF * BK * 2, STAGE_BYTES = 8 * HTB, NXCD = 8, WGM = 8;
__host__ __device__ __forceinline__ int lds_byte(int r, int c) { const int st = (r >> 4) * 2 + (c >> 5), rr = r & 15, cc = c & 31, ob = rr * 64 + cc * 2; return st * 1024 + (ob ^ (((ob >> 9) & 1) << 5)); }
__host__ __device__ __forceinline__ void stage_rc(int b, int& R, int& C) { const int st = b / 1024, sb = b % 1024, swz = sb ^ (((sb >> 9) & 1) << 5); R = (st >> 1) * 16 + swz / 64; C = (st & 1) * 32 + (swz % 64) / 2; }
__host__ __device__ __forceinline__ int perm32(int rho) { const int n = rho >> 4, i = rho & 15; return 8 * (i >> 2) + 4 * n + (i & 3); }
struct Unit { int pm, pn; };
struct Gemm { const bf16_t* A; const bf16_t* Bt; int M, N, K, lda; };
struct StaticOrder {
    int nM, nN, nwg, G, c;
    __host__ __device__ void init(int M_, int N_, int G_, int c_) { nM = M_ / BM; nN = N_ / BM; nwg = nM * nN; G = G_; c = c_; }
    __host__ __device__ bool next(int i, Unit& u) const {
        const long L = (long)i * G + c; if (L >= nwg) return false;
        int wgid = (int)L; { const int q = nwg / NXCD, r = nwg % NXCD, xcd = wgid % NXCD, off = wgid / NXCD; wgid = (xcd < r ? xcd * (q + 1) : r * (q + 1) + (xcd - r) * q) + off; }
        const int nig = WGM * nN, gid = wgid / nig, fm = gid * WGM, gsz = (nM - fm) < WGM ? (nM - fm) : WGM;
        u.pm = fm + ((wgid % nig) % gsz); u.pn = (wgid % nig) / gsz; return true;
    }
};
__device__ __forceinline__ unsigned cvt_pk_bf16(float lo, float hi) { unsigned r; asm volatile("v_cvt_pk_bf16_f32 %0, %1, %2" : "=v"(r) : "v"(lo), "v"(hi)); return r; }
struct EpiBf16 {
    static constexpr bool PERM = true, AFTER_DRAIN = false;
    __device__ __forceinline__ void khook(f32x4 (&)[2][2][4][2], const Unit&, int, int, int) const {}
    bf16_t* O; int ldc;
    __device__ __forceinline__ void operator()(const f32x4 (&acc)[2][2][4][2], const Unit& u, int wr, int wc, int fr, int fq) const {
        const int row0 = u.pm * BM + wr * 64 + fr, col0 = u.pn * BM + wc * 32 + 8 * fq;
#pragma unroll
        for (int ai = 0; ai < 2; ++ai)
#pragma unroll
            for (int m = 0; m < 4; ++m) { bf16_t* rowp = O + (size_t)(row0 + ai * HALF + m * 16) * ldc + col0;
#pragma unroll
                for (int bj = 0; bj < 2; ++bj) { const f32x4 v0 = acc[ai][bj][m][0], v1 = acc[ai][bj][m][1];
                    u32x4 w; w.x = cvt_pk_bf16(v0[0], v0[1]); w.y = cvt_pk_bf16(v0[2], v0[3]); w.z = cvt_pk_bf16(v1[0], v1[1]); w.w = cvt_pk_bf16(v1[2], v1[3]);
                    *(u32x4*)(rowp + bj * HALF) = w; } }
    }
};
__device__ __forceinline__ float silu_fast(float g) { return g * __builtin_amdgcn_rcpf(1.f + __builtin_amdgcn_exp2f(-1.4426950408889634f * g)); }
struct EpiSwiglu {
    static constexpr bool PERM = true, AFTER_DRAIN = false;
    __device__ __forceinline__ void khook(f32x4 (&)[2][2][4][2], const Unit&, int, int, int) const {}
    bf16_t* O; int ldc;
    __device__ __forceinline__ void operator()(const f32x4 (&acc)[2][2][4][2], const Unit& u, int wr, int wc, int fr, int fq) const {
        const int row0 = u.pm * BM + wr * 64 + fr, col0 = u.pn * HALF + wc * 32 + 8 * fq;
#pragma unroll
        for (int ai = 0; ai < 2; ++ai)
#pragma unroll
            for (int m = 0; m < 4; ++m) { bf16_t* rowp = O + (size_t)(row0 + ai * HALF + m * 16) * ldc + col0;
                const f32x4 g0 = acc[ai][0][m][0], g1 = acc[ai][0][m][1], u0 = acc[ai][1][m][0], u1 = acc[ai][1][m][1];
                u32x4 w;
                w.x = cvt_pk_bf16(silu_fast(g0[0]) * u0[0], silu_fast(g0[1]) * u0[1]); w.y = cvt_pk_bf16(silu_fast(g0[2]) * u0[2], silu_fast(g0[3]) * u0[3]);
                w.z = cvt_pk_bf16(silu_fast(g1[0]) * u1[0], silu_fast(g1[1]) * u1[1]); w.w = cvt_pk_bf16(silu_fast(g1[2]) * u1[2], silu_fast(g1[3]) * u1[3]);
                *(u32x4*)rowp = w; }
    }
};
struct EpiRes {
    static constexpr bool PERM = false, AFTER_DRAIN = false;
    __device__ __forceinline__ void khook(f32x4 (&)[2][2][4][2], const Unit&, int, int, int) const {}
    const float* base; float* out; const float* gate;
    __device__ __forceinline__ void operator()(const f32x4 (&acc)[2][2][4][2], const Unit& u, int wr, int wc, int fr, int fq) const {
        const int b = (u.pm * BM) / SEQ, col0 = u.pn * BM + wc * 32 + 4 * fq;
        f32x4 gv[2][2];
#pragma unroll
        for (int bj = 0; bj < 2; ++bj)
#pragma unroll
            for (int n = 0; n < 2; ++n) gv[bj][n] = *(const f32x4*)(gate + (size_t)b * 6144 + col0 + bj * HALF + n * 16);
#pragma unroll
        for (int ai = 0; ai < 2; ++ai) {
            f32x4 bs[4][2][2];
#pragma unroll
            for (int m = 0; m < 4; ++m) { const size_t off = (size_t)(u.pm * BM + ai * HALF + wr * 64 + m * 16 + fr) * D + col0;
#pragma unroll
                for (int bj = 0; bj < 2; ++bj)
#pragma unroll
                    for (int n = 0; n < 2; ++n) bs[m][bj][n] = __builtin_nontemporal_load((const f32x4*)(base + off + bj * HALF + n * 16)); }
            asm volatile("" ::: "memory");
#pragma unroll
            for (int m = 0; m < 4; ++m) { const size_t off = (size_t)(u.pm * BM + ai * HALF + wr * 64 + m * 16 + fr) * D + col0;
#pragma unroll
                for (int bj = 0; bj < 2; ++bj)
#pragma unroll
                    for (int n = 0; n < 2; ++n) __builtin_nontemporal_store(bs[m][bj][n] + gv[bj][n] * acc[ai][bj][m][n], (f32x4*)(out + off + bj * HALF + n * 16)); }
            asm volatile("" ::: "memory");
        }
    }
};


constexpr int ST_OFF = 131072;
struct OneUnit { int pm, pn; __device__ __forceinline__ bool next(int i, Unit& u) const { if (i) return false; u.pm = pm; u.pn = pn; return true; } };
struct EpiResHook {
    static constexpr bool PERM = false, AFTER_DRAIN = false;
    const float* base; float* out; const float* gate; const float* SS; const PG8_LAS float* tab;
    __device__ __forceinline__ void sums(size_t row, float& ssb, float& smla) const {
        const f32x4 a = *(const f32x4*)(SS + row * 16), b = *(const f32x4*)(SS + row * 16 + 4), c = *(const f32x4*)(SS + row * 16 + 8);
        ssb = ((a[0] + a[1]) + (a[2] + a[3])) + ((b[0] + b[1]) + (b[2] + b[3])); smla = (c[0] + c[1]) + (c[2] + c[3]);
    }
    __device__ __forceinline__ void khook(f32x4 (&acc)[2][2][4][2], const Unit& u, int t, int wr, int fr) const {
        if (t != 8) return;
#pragma unroll
        for (int ai = 0; ai < 2; ++ai)
#pragma unroll
            for (int m = 0; m < 4; ++m) { float ratio;
                if (tab) ratio = tab[ai * HALF + wr * 64 + m * 16 + fr];
                else { float ssb, smla; sums((size_t)(u.pm * BM + ai * HALF + wr * 64 + m * 16 + fr), ssb, smla); ratio = sqrtf((smla * (1.f / 512) + EPS) / (ssb * (1.f / 512) + EPS)); }
#pragma unroll
                for (int bj = 0; bj < 2; ++bj)
#pragma unroll
                    for (int n = 0; n < 2; ++n) acc[ai][bj][m][n] *= ratio; }
    }
    __device__ __forceinline__ void operator()(const f32x4 (&acc)[2][2][4][2], const Unit& u, int wr, int wc, int fr, int fq) const {
        const int b = (u.pm * BM) / SEQ, col0 = u.pn * BM + wc * 32 + 4 * fq;
        f32x4 gv[2][2];
#pragma unroll
        for (int bj = 0; bj < 2; ++bj)
#pragma unroll
            for (int n = 0; n < 2; ++n) gv[bj][n] = *(const f32x4*)(gate + (size_t)b * 6144 + col0 + bj * HALF + n * 16);
#pragma unroll
        for (int ai = 0; ai < 2; ++ai)
#pragma unroll
            for (int m = 0; m < 4; ++m) { const size_t row = (size_t)(u.pm * BM + ai * HALF + wr * 64 + m * 16 + fr), off = row * D + col0;
                float rm;
                if (tab) rm = tab[256 + ai * HALF + wr * 64 + m * 16 + fr];
                else { float ssb, smla; sums(row, ssb, smla); rm = rsqrtf(smla * (1.f / 512) + EPS); }
#pragma unroll
                for (int bj = 0; bj < 2; ++bj)
#pragma unroll
                    for (int n = 0; n < 2; ++n) { const f32x4 bs = *(const f32x4*)(base + off + bj * HALF + n * 16);
                        *(f32x4*)(out + off + bj * HALF + n * 16) = bs + gv[bj][n] * (acc[ai][bj][m][n] * rm); } }
    }
};

struct EpiResNorm {
    static constexpr bool PERM = true, AFTER_DRAIN = true;
    const float* base; float* out; const float* modp; const PG8_LAS float* tab; const float* gffn; bf16_t* Hn; unsigned* xbuf; unsigned* cnt;
    __device__ __forceinline__ void khook(f32x4 (&acc)[2][2][4][2], const Unit&, int t, int wr, int fr) const {
        if (t != 8) return;
#pragma unroll
        for (int ai = 0; ai < 2; ++ai)
#pragma unroll
            for (int m = 0; m < 4; ++m) { const float ratio = tab[ai * HALF + wr * 64 + m * 16 + fr];
#pragma unroll
                for (int bj = 0; bj < 2; ++bj)
#pragma unroll
                    for (int n = 0; n < 2; ++n) acc[ai][bj][m][n] *= ratio; }
    }
    __device__ __forceinline__ void fused(f32x4 (&acc)[2][2][4][2], const Unit& u, int wr, int wc, int fr, int fq, PG8_LAS unsigned char* lds, int lane) const {
        PG8_LAS float* P = (PG8_LAS float*)lds;
        PG8_LAS float* S = (PG8_LAS float*)(lds + 8192);
        PG8_LAS unsigned* flag = (PG8_LAS unsigned*)(lds + 8192 + 2048);
        const int wid = wr * 4 + wc, b = (u.pm * BM) / SEQ, col0 = u.pn * BM + wc * 32 + 8 * fq;
        const float* mb = modp + (size_t)b * 6144;
        {
            f32x4 gv[2][2];
#pragma unroll
            for (int bj = 0; bj < 2; ++bj)
#pragma unroll
                for (int n = 0; n < 2; ++n) gv[bj][n] = *(const f32x4*)(mb + 2 * 1024 + col0 + bj * HALF + n * 4);
#pragma unroll
            for (int ai = 0; ai < 2; ++ai)
#pragma unroll
                for (int m = 0; m < 4; ++m) { const int r = ai * HALF + wr * 64 + m * 16 + fr; const float rm = tab[256 + r]; const float* bp = base + (size_t)(u.pm * BM + r) * D + col0;
#pragma unroll
                    for (int bj = 0; bj < 2; ++bj)
#pragma unroll
                        for (int n = 0; n < 2; ++n) acc[ai][bj][m][n] = __builtin_nontemporal_load((const f32x4*)(bp + bj * HALF + n * 4)) + gv[bj][n] * (acc[ai][bj][m][n] * rm);
                    asm volatile("" : "+v"(acc[ai][0][m][0]), "+v"(acc[ai][0][m][1]), "+v"(acc[ai][1][m][0]), "+v"(acc[ai][1][m][1]));
                    if (m == 3) asm volatile("" ::: "memory"); }
        }
#pragma unroll
        for (int ai = 0; ai < 2; ++ai)
#pragma unroll
            for (int m = 0; m < 4; ++m) { float s = 0.f;
#pragma unroll
                for (int bj = 0; bj < 2; ++bj)
#pragma unroll
                    for (int n = 0; n < 2; ++n) { const f32x4 v = acc[ai][bj][m][n]; s += (v[0] * v[0] + v[1] * v[1]) + (v[2] * v[2] + v[3] * v[3]); }
                s += __shfl_xor(s, 16); s += __shfl_xor(s, 32);
                if (fq == 0) P[(ai * HALF + wr * 64 + m * 16 + fr) * 4 + wc] = s; }
        __syncthreads();
        const int row = wid * 32 + (lane & 31);
        if (lane < 32) { const float tot = (P[row * 4] + P[row * 4 + 1]) + (P[row * 4 + 2] + P[row * 4 + 3]);
            __hip_atomic_store(xbuf + ((size_t)(u.pm * BM + row) * 4 + u.pn), __float_as_uint(tot), __ATOMIC_RELAXED, __HIP_MEMORY_SCOPE_AGENT); }
        asm volatile("s_waitcnt vmcnt(0)" ::: "memory");
        if (lane == 0) __hip_atomic_fetch_add(cnt + 64 * u.pm, 1u, __ATOMIC_RELAXED, __HIP_MEMORY_SCOPE_AGENT);
        if (wid == 0) {
            unsigned ok = 0u;
            for (unsigned sp = 0; sp < (1u << 22); ++sp) {
                if ((unsigned)__builtin_amdgcn_readfirstlane(__hip_atomic_load(cnt + 64 * u.pm, __ATOMIC_RELAXED, __HIP_MEMORY_SCOPE_AGENT)) >= 32u) { ok = 1u; break; }
                __builtin_amdgcn_s_sleep(2);
            }
            __builtin_amdgcn_fence(__ATOMIC_ACQUIRE, "agent");
            if (lane == 0) flag[0] = ok;
        }
        asm volatile("s_waitcnt vmcnt(0) lgkmcnt(0)" ::: "memory");
        __syncthreads();
        if (lane < 32) { const unsigned* sl = xbuf + (size_t)(u.pm * BM + row) * 4; float t = 0.f;
#pragma unroll
            for (int j = 0; j < 4; ++j) t += __uint_as_float(__hip_atomic_load(sl + j, __ATOMIC_RELAXED, __HIP_MEMORY_SCOPE_AGENT));
            S[row] = (flag[0] != 0u) ? rsqrtf(t * (1.f / D) + EPS) : __builtin_nanf(""); }
        __syncthreads();
        {
            f32x4 gs[2][2], sh[2][2];
#pragma unroll
            for (int bj = 0; bj < 2; ++bj)
#pragma unroll
                for (int n = 0; n < 2; ++n) { const int col = col0 + bj * HALF + n * 4;
                    gs[bj][n] = *(const f32x4*)(gffn + col) * (*(const f32x4*)(mb + 4 * 1024 + col) + 1.f); sh[bj][n] = *(const f32x4*)(mb + 3 * 1024 + col); }
#pragma unroll
            for (int ai = 0; ai < 2; ++ai)
#pragma unroll
                for (int m = 0; m < 4; ++m) { const int r = ai * HALF + wr * 64 + m * 16 + fr; const size_t off = (size_t)(u.pm * BM + r) * D + col0; const float rs = S[r];
#pragma unroll
                    for (int bj = 0; bj < 2; ++bj) { const f32x4 xa = acc[ai][bj][m][0], xb = acc[ai][bj][m][1];
                        __builtin_nontemporal_store(xa, (f32x4*)(out + off + bj * HALF)); __builtin_nontemporal_store(xb, (f32x4*)(out + off + bj * HALF + 4));
                        const f32x4 ha = xa * rs * gs[bj][0] + sh[bj][0], hb = xb * rs * gs[bj][1] + sh[bj][1];
                        u32x4 w; w.x = cvt_pk_bf16(ha[0], ha[1]); w.y = cvt_pk_bf16(ha[2], ha[3]); w.z = cvt_pk_bf16(hb[0], hb[1]); w.w = cvt_pk_bf16(hb[2], hb[3]);
                        *(u32x4*)(Hn + off + bj * HALF) = w; }
                    if (m & 1) asm volatile("" ::: "memory"); }
        }
    }
};
struct EpiQ {
    static constexpr bool PERM = true, AFTER_DRAIN = true;
    bf16_t* QM; const float* q_norm; const float* COS; const float* SIN;
    __device__ __forceinline__ void khook(f32x4 (&)[2][2][4][2], const Unit&, int, int, int) const {}
    __device__ __forceinline__ void fused(f32x4 (&acc)[2][2][4][2], const Unit& u, int wr, int wc, int fr, int fq, PG8_LAS unsigned char* lds, int lane) const {
        const PG8_LAS float* st = (const PG8_LAS float*)(lds + ST_OFF);
        PG8_LAS float* P = (PG8_LAS float*)lds;
        PG8_LAS float* X = (PG8_LAS float*)(lds + 8192);
#pragma unroll
        for (int ai = 0; ai < 2; ++ai)
#pragma unroll
            for (int m = 0; m < 4; ++m) { const int r = ai * HALF + wr * 64 + m * 16 + fr; const float rs = st[r]; float s = 0.f;
#pragma unroll
                for (int bj = 0; bj < 2; ++bj)
#pragma unroll
                    for (int n = 0; n < 2; ++n) { f32x4 v = acc[ai][bj][m][n] * rs; acc[ai][bj][m][n] = v; s += (v[0] * v[0] + v[1] * v[1]) + (v[2] * v[2] + v[3] * v[3]); }
                s += __shfl_xor(s, 16); s += __shfl_xor(s, 32);
                if (fq == 0) P[r * 4 + wc] = s; }
        __syncthreads();
        f32x4 g[2][2];
#pragma unroll
        for (int bj = 0; bj < 2; ++bj)
#pragma unroll
            for (int n = 0; n < 2; ++n) { const int j0 = bj * HALF + wc * 32 + 8 * fq + 4 * n; g[bj][n] = (j0 < MQK) ? *(const f32x4*)(q_norm + j0) : (f32x4){0.f, 0.f, 0.f, 0.f}; }
#pragma unroll
        for (int ai = 0; ai < 2; ++ai)
#pragma unroll
            for (int m = 0; m < 4; ++m) { const int r = ai * HALF + wr * 64 + m * 16 + fr;
                const float tot = (P[r * 4] + P[r * 4 + 1]) + (P[r * 4 + 2] + P[r * 4 + 3]);
                const float rq = rsqrtf(tot * (1.f / MQK) + EPS) * 0.10411754714f;
#pragma unroll
                for (int bj = 0; bj < 2; ++bj)
#pragma unroll
                    for (int n = 0; n < 2; ++n) acc[ai][bj][m][n] = acc[ai][bj][m][n] * g[bj][n] * rq; }
        if (wc < 2) {
#pragma unroll
            for (int ai = 0; ai < 2; ++ai)
#pragma unroll
                for (int m = 0; m < 4; ++m)
#pragma unroll
                    for (int n = 0; n < 2; ++n)
#pragma unroll
                        for (int i = 0; i < 4; ++i) X[((wr * 2 + wc) * 64 + (ai * 4 + m) * 8 + n * 4 + i) * 64 + lane] = acc[ai][1][m][n][i];
        }
        __syncthreads();
        if (wc < 2) {
#pragma unroll
            for (int ai = 0; ai < 2; ++ai)
#pragma unroll
                for (int m = 0; m < 4; ++m) { const size_t row = (size_t)(u.pm * BM + ai * HALF + wr * 64 + m * 16 + fr);
#pragma unroll
                    for (int n = 0; n < 2; ++n) { const f32x4 cs = *(const f32x4*)(COS + row * 32 + 8 * fq + 4 * n), sn = *(const f32x4*)(SIN + row * 32 + 8 * fq + 4 * n);
                        f32x4 v = acc[ai][1][m][n];
#pragma unroll
                        for (int i = 0; i < 4; ++i) { const float part = X[((wr * 2 + (1 - wc)) * 64 + (ai * 4 + m) * 8 + n * 4 + i) * 64 + lane];
                            v[i] = (wc == 0) ? (v[i] * cs[i] - part * sn[i]) : (v[i] * cs[i] + part * sn[i]); }
                        acc[ai][1][m][n] = v; } }
        }
#pragma unroll
        for (int ai = 0; ai < 2; ++ai)
#pragma unroll
            for (int m = 0; m < 4; ++m) { const size_t row = (size_t)(u.pm * BM + ai * HALF + wr * 64 + m * 16 + fr);
                bf16_t* rowp = QM + (row * 4 + u.pn) * MQK + wc * 32 + 8 * fq;
#pragma unroll
                for (int bj = 0; bj < 2; ++bj) { if (bj == 1 && wc >= 2) continue;
                    const f32x4 v0 = acc[ai][bj][m][0], v1 = acc[ai][bj][m][1];
                    u32x4 w; w.x = cvt_pk_bf16(v0[0], v0[1]); w.y = cvt_pk_bf16(v0[2], v0[3]); w.z = cvt_pk_bf16(v1[0], v1[1]); w.w = cvt_pk_bf16(v1[2], v1[3]);
                    *(u32x4*)(rowp + bj * HALF) = w; } }
        __syncthreads();
    }
};
struct EpiKV {
    static constexpr bool PERM = true, AFTER_DRAIN = true;
    bf16_t* KM; bf16_t* VM; const float* k_nope_norm;
    __device__ __forceinline__ void khook(f32x4 (&)[2][2][4][2], const Unit&, int, int, int) const {}
    __device__ __forceinline__ void fused(f32x4 (&acc)[2][2][4][2], const Unit& u, int wr, int wc, int fr, int fq, PG8_LAS unsigned char* lds, int lane) const {
        const PG8_LAS float* st = (const PG8_LAS float*)(lds + ST_OFF) + 256;
        PG8_LAS float* P = (PG8_LAS float*)lds;
#pragma unroll
        for (int ai = 0; ai < 2; ++ai)
#pragma unroll
            for (int m = 0; m < 4; ++m) { const int r = ai * HALF + wr * 64 + m * 16 + fr; const float rs = st[r]; float s = 0.f;
#pragma unroll
                for (int bj = 0; bj < 2; ++bj)
#pragma unroll
                    for (int n = 0; n < 2; ++n) { f32x4 v = acc[ai][bj][m][n] * rs; acc[ai][bj][m][n] = v; if (bj == 0) s += (v[0] * v[0] + v[1] * v[1]) + (v[2] * v[2] + v[3] * v[3]); }
                s += __shfl_xor(s, 16); s += __shfl_xor(s, 32);
                if (fq == 0) P[r * 4 + wc] = s; }
        __syncthreads();
        f32x4 g[2];
#pragma unroll
        for (int n = 0; n < 2; ++n) g[n] = *(const f32x4*)(k_nope_norm + wc * 32 + 8 * fq + 4 * n);
#pragma unroll
        for (int ai = 0; ai < 2; ++ai)
#pragma unroll
            for (int m = 0; m < 4; ++m) { const int r = ai * HALF + wr * 64 + m * 16 + fr; const size_t row = (size_t)(u.pm * BM + r);
                const float tot = (P[r * 4] + P[r * 4 + 1]) + (P[r * 4 + 2] + P[r * 4 + 3]);
                const float rk = rsqrtf(tot * (1.f / MNOPE) + EPS);
                const f32x4 k0 = acc[ai][0][m][0] * g[0] * rk, k1 = acc[ai][0][m][1] * g[1] * rk, v0 = acc[ai][1][m][0], v1 = acc[ai][1][m][1];
                u32x4 w; w.x = cvt_pk_bf16(k0[0], k0[1]); w.y = cvt_pk_bf16(k0[2], k0[3]); w.z = cvt_pk_bf16(k1[0], k1[1]); w.w = cvt_pk_bf16(k1[2], k1[3]);
                *(u32x4*)(KM + (row * 4 + u.pn) * MQK + wc * 32 + 8 * fq) = w;
                w.x = cvt_pk_bf16(v0[0], v0[1]); w.y = cvt_pk_bf16(v0[2], v0[3]); w.z = cvt_pk_bf16(v1[0], v1[1]); w.w = cvt_pk_bf16(v1[2], v1[3]);
                *(u32x4*)(VM + (row * 4 + u.pn) * MV + wc * 32 + 8 * fq) = w; }
        __syncthreads();
    }
};

template <class Epi, class Sched, bool ALIGN_EPI>
__device__ __forceinline__ void gemm_phase(PG8_LAS unsigned char* lds, const Gemm g, const Sched& S, const Epi& E) {
    int tid_ = threadIdx.x; asm volatile("" : "+v"(tid_));
    const int tid = tid_, wid = __builtin_amdgcn_readfirstlane(tid >> 6), lane = tid & 63, wr = wid >> 2, wc = wid & 3, fr = lane & 15, fq = lane >> 4;
    const int K = g.K, nt = K / BK, lda = g.lda;
    unsigned voffA[2], voffB[2];
#pragma unroll
    for (int i = 0; i < 2; ++i) { int R, C; stage_rc(tid * 16 + i * 8192, R, C); const int Rb = Epi::PERM ? ((R & ~31) + perm32(R & 31)) : R;
        voffA[i] = (unsigned)(R * lda + C) * 2u; voffB[i] = (unsigned)(Rb * K + C) * 2u; }
    const size_t kstep = (size_t)(BK * 2);
    const size_t hstepA = (size_t)HALF * lda * 2, hstepB = (size_t)HALF * K * 2;
    const size_t tstepA = 2 * hstepA, tstepB = 2 * hstepB;
    const unsigned ldsw = (unsigned)wid * 1024u;
    const int aoff = lds_byte(wr * 64 + fr, fq * 8), boff = lds_byte(wc * 32 + fr, fq * 8);
#define PG8_SA(b, h) (((b) * 2 + (h)) * HTB)
#define PG8_SB(b, h) ((4 + (b) * 2 + (h)) * HTB)
#define PG8_STAGE(bufoff, gbase, voff) do { _Pragma("unroll") for (int _i = 0; _i < 2; ++_i) \
        __builtin_amdgcn_global_load_lds((const unsigned*)((const char*)(gbase) + (voff)[_i]), (PG8_LAS unsigned*)(lds + (bufoff) + ldsw + _i * 8192), 16, 0, 0); } while (0)
#define PG8_LDA(dst, b, h) do { _Pragma("unroll") for (int m = 0; m < 4; ++m) _Pragma("unroll") for (int k = 0; k < 2; ++k) dst[m][k] = *(const PG8_LAS bf16x8*)(lds + PG8_SA(b, h) + aoff + m * 2048 + k * 1024); } while (0)
#define PG8_LDB(dst, b, h) do { _Pragma("unroll") for (int n = 0; n < 2; ++n) _Pragma("unroll") for (int k = 0; k < 2; ++k) dst[n][k] = *(const PG8_LAS bf16x8*)(lds + PG8_SB(b, h) + boff + n * 2048 + k * 1024); } while (0)
#define PG8_MMA(ai, bj, At, Bt) do { __builtin_amdgcn_s_setprio(1); _Pragma("unroll") for (int m = 0; m < 4; ++m) _Pragma("unroll") for (int n = 0; n < 2; ++n) _Pragma("unroll") for (int k = 0; k < 2; ++k) \
        acc[ai][bj][m][n] = __builtin_amdgcn_mfma_f32_16x16x32_bf16(Bt[n][k], At[m][k], acc[ai][bj][m][n], 0, 0, 0); __builtin_amdgcn_s_setprio(0); } while (0)
#define PG8_WAIT_V(n) asm volatile("s_waitcnt vmcnt(" #n ")" ::: "memory")
#define PG8_WAIT_L(n) asm volatile("s_waitcnt lgkmcnt(" #n ")" ::: "memory")
#define PG8_BAR __builtin_amdgcn_s_barrier()
#define PG8_SCHED __builtin_amdgcn_sched_barrier(0)
    Unit cur, nxt; int ui = 0;
    if (!S.next(0, cur)) return;
    f32x4 acc[2][2][4][2];
#pragma unroll
    for (int a = 0; a < 2; ++a)
#pragma unroll
        for (int b = 0; b < 2; ++b)
#pragma unroll
            for (int m = 0; m < 4; ++m)
#pragma unroll
                for (int n = 0; n < 2; ++n) acc[a][b][m][n] = (f32x4){0.f, 0.f, 0.f, 0.f};
    bf16x8 At[4][2], B0[2][2], B1[2][2];
    const char* cA = (const char*)g.A + (size_t)cur.pm * tstepA; const char* cB = (const char*)g.Bt + (size_t)cur.pn * tstepB;
    PG8_STAGE(PG8_SB(0, 0), cB, voffB); PG8_STAGE(PG8_SB(0, 1), cB + hstepB, voffB); PG8_STAGE(PG8_SA(0, 0), cA, voffA); PG8_STAGE(PG8_SA(0, 1), cA + hstepA, voffA);
    if (wr == 1) PG8_BAR;
    PG8_WAIT_V(2); PG8_BAR;
    PG8_STAGE(PG8_SB(1, 0), cB + kstep, voffB); PG8_STAGE(PG8_SA(1, 0), cA + kstep, voffA); PG8_STAGE(PG8_SB(1, 1), cB + hstepB + kstep, voffB);
    PG8_WAIT_V(6); PG8_BAR;
    for (;;) {
        const bool has_next = S.next(ui + 1, nxt);
        const char* nA = has_next ? (const char*)g.A + (size_t)nxt.pm * tstepA : cA; const char* nB = has_next ? (const char*)g.Bt + (size_t)nxt.pn * tstepB : cB;
#pragma nounroll
        for (int t = 0; t < nt; t += 2) {
            const bool last = (t == nt - 2);
            const char* a1 = cA + (size_t)(t + 1) * kstep;
            const char* a2 = last ? nA : cA + (size_t)(t + 2) * kstep; const char* b2 = last ? nB : cB + (size_t)(t + 2) * kstep;
            const char* a3 = a2 + kstep; const char* b3 = b2 + kstep;
            E.khook(acc, cur, t, wr, fr);
            PG8_LDB(B0, 0, 0); PG8_LDB(B1, 0, 1); PG8_SCHED; PG8_LDA(At, 0, 0); PG8_STAGE(PG8_SA(1, 1), a1 + hstepA, voffA);
            PG8_WAIT_V(8); PG8_WAIT_L(0); PG8_BAR; PG8_MMA(0, 0, At, B0); PG8_MMA(0, 1, At, B1); PG8_BAR; PG8_SCHED;
            PG8_LDA(At, 0, 1); PG8_STAGE(PG8_SB(0, 0), b2, voffB); PG8_STAGE(PG8_SB(0, 1), b2 + hstepB, voffB); PG8_STAGE(PG8_SA(0, 0), a2, voffA);
            PG8_WAIT_V(8); PG8_WAIT_L(0); PG8_BAR; PG8_MMA(1, 0, At, B0); PG8_MMA(1, 1, At, B1); PG8_BAR; PG8_SCHED;
            PG8_LDB(B0, 1, 0); PG8_LDB(B1, 1, 1); PG8_SCHED; PG8_LDA(At, 1, 0); PG8_STAGE(PG8_SA(0, 1), a2 + hstepA, voffA);
            PG8_WAIT_V(8); PG8_WAIT_L(0); PG8_BAR; PG8_MMA(0, 0, At, B0); PG8_MMA(0, 1, At, B1); PG8_BAR; PG8_SCHED;
            PG8_LDA(At, 1, 1); PG8_STAGE(PG8_SB(1, 0), b3, voffB); PG8_STAGE(PG8_SB(1, 1), b3 + hstepB, voffB); PG8_STAGE(PG8_SA(1, 0), a3, voffA);
            PG8_WAIT_V(8); PG8_WAIT_L(0); PG8_BAR; PG8_MMA(1, 0, At, B0); PG8_MMA(1, 1, At, B1); PG8_BAR; PG8_SCHED;
        }
        if constexpr (ALIGN_EPI) { if (wr == 0) PG8_BAR; }
        if constexpr (!Epi::AFTER_DRAIN) E(acc, cur, wr, wc, fr, fq);
        if (!has_next) break;
#pragma unroll
        for (int a = 0; a < 2; ++a)
#pragma unroll
            for (int b = 0; b < 2; ++b)
#pragma unroll
                for (int m = 0; m < 4; ++m)
#pragma unroll
                    for (int n = 0; n < 2; ++n) acc[a][b][m][n] = (f32x4){0.f, 0.f, 0.f, 0.f};
        cur = nxt; cA = nA; cB = nB; ++ui;
        if constexpr (ALIGN_EPI) { if (wr == 1) PG8_BAR; }
    }
    PG8_WAIT_V(0);
    if constexpr (!ALIGN_EPI) { if (wr == 0) PG8_BAR; }
    PG8_BAR;
    if constexpr (Epi::AFTER_DRAIN) E.fused(acc, cur, wr, wc, fr, fq, lds, lane);
#undef PG8_SA
#undef PG8_SB
#undef PG8_STAGE
#undef PG8_LDA
#undef PG8_LDB
#undef PG8_MMA
#undef PG8_WAIT_V
#undef PG8_WAIT_L
#undef PG8_BAR
#undef PG8_SCHED
}
}


namespace att {
typedef short bf16x8 __attribute__((ext_vector_type(8)));
typedef short s16x4 __attribute__((ext_vector_type(4)));
typedef _Float16 f16x8 __attribute__((ext_vector_type(8)));
typedef _Float16 f16x2 __attribute__((ext_vector_type(2)));
typedef float f32x16 __attribute__((ext_vector_type(16)));
typedef float f32x2v __attribute__((ext_vector_type(2)));
typedef __bf16 bf16x2_t __attribute__((ext_vector_type(2)));
constexpr int BUFB = 46080, KV_OFF = 25600;
constexpr int WS_OFF = 136192, SLOT_OFF = WS_OFF + 2048, FLAG_OFF = SLOT_OFF + 64;
__device__ __forceinline__ int crow(int r, int hi) { return (r & 3) + 8 * (r >> 2) + 4 * hi; }
__device__ __forceinline__ constexpr int crowc(int r) { return (r & 3) + 8 * (r >> 2); }
__device__ __forceinline__ unsigned cvtpk_bf16(float lo, float hi) { f32x2v v = {lo, hi}; bf16x2_t b = __builtin_convertvector(v, bf16x2_t); return __builtin_bit_cast(unsigned, b); }
__device__ __forceinline__ unsigned cvtpk_f16(float lo, float hi) { f32x2v v = {lo, hi}; f16x2 b = __builtin_convertvector(v, f16x2); return __builtin_bit_cast(unsigned, b); }
#define ATT_EX2(x) __builtin_amdgcn_exp2f(x)
#define ATT_LG2(x) __builtin_amdgcn_logf(x)

template <int DQK, int DV> struct TileRegs { v4u k[DQK / 64]; v4u v[DV / 64]; };
template <int DQK, int DV>
__device__ __forceinline__ void tile_load(TileRegs<DQK, DV>& R, const bf16_t* Kg, int ks, const bf16_t* Vg, int vs, int k0, int) {
    const int tid = tid_now();
#pragma unroll
    for (int i = 0; i < DQK / 64; ++i) { const int ch = tid + 512 * i, row = ch / (DQK / 8), c = ch % (DQK / 8); R.k[i] = *(const v4u*)(Kg + (size_t)(k0 + row) * ks + c * 8); }
#pragma unroll
    for (int i = 0; i < DV / 64; ++i) { const int ch = tid + 512 * i, row = ch / (DV / 8), c = ch % (DV / 8); R.v[i] = *(const v4u*)(Vg + (size_t)(k0 + row) * vs + c * 8); }
}
template <int DQK, int DV>
__device__ __forceinline__ void tile_store(const TileRegs<DQK, DV>& R, LAS unsigned char* buf, int, const int voff = KV_OFF) {
    const int tid = tid_now();
    constexpr int KROWB = (DQK + 8) * 2, VROWB = (DV + 32) * 2;
#pragma unroll
    for (int i = 0; i < DQK / 64; ++i) { const int ch = tid + 512 * i, row = ch / (DQK / 8), c = ch % (DQK / 8); *(LAS v4u*)(buf + row * KROWB + c * 16) = R.k[i]; }
#pragma unroll
    for (int i = 0; i < DV / 64; ++i) { const int ch = tid + 512 * i, row = ch / (DV / 8), c = ch % (DV / 8); *(LAS v4u*)(buf + voff + row * VROWB + c * 16) = R.v[i]; }
}
typedef short v4i16_t __attribute__((ext_vector_type(4)));
__device__ __forceinline__ s16x4 vtr(const LAS unsigned char* p) { return __builtin_bit_cast(s16x4, __builtin_amdgcn_ds_read_tr16_b64_v4i16((LAS v4i16_t*)p)); }
template <int VROWB>
__device__ __forceinline__ bf16x8 vfrag(const LAS unsigned char* vb, int db, int p, int s2) {
    const s16x4 lo = vtr(vb + (32 * p + 16 * s2) * VROWB + 64 * db);
    const s16x4 hi = vtr(vb + (32 * p + 16 * s2 + 8) * VROWB + 64 * db);
    return (bf16x8){lo[0], lo[1], lo[2], lo[3], hi[0], hi[1], hi[2], hi[3]};
}
#define ATT_PACK8(X, B) __builtin_bit_cast(bf16x8, (v4u){cvtpk_bf16(X[B], X[B + 1]), cvtpk_bf16(X[B + 2], X[B + 3]), cvtpk_bf16(X[B + 4], X[B + 5]), cvtpk_bf16(X[B + 6], X[B + 7])})
#define ATT_PACKH8(X, B) __builtin_bit_cast(f16x8, (v4u){cvtpk_f16(X[B], X[B + 1]), cvtpk_f16(X[B + 2], X[B + 3]), cvtpk_f16(X[B + 4], X[B + 5]), cvtpk_f16(X[B + 6], X[B + 7])})

__device__ __forceinline__ void sb_tile(const bool DIAG, const LAS unsigned char* lds, const int voff, const bf16x8 (&qf)[4], const f16x8 (&Ud)[2], f16x8 ones, f32x16& o0, f32x16& o1, float& carry, int k0, int qw0, int r32, int hi) {
    constexpr int KROWB = 144;
    f32x16 p0 = {}, p1 = {};
    const LAS unsigned char* kb = lds + r32 * KROWB + hi * 16;
#pragma unroll
    for (int s = 0; s < 4; ++s) {
        const bf16x8 a0 = *(const LAS bf16x8*)(kb + s * 32), a1 = *(const LAS bf16x8*)(kb + 32 * KROWB + s * 32);
        p0 = __builtin_amdgcn_mfma_f32_32x32x16_bf16(a0, qf[s], p0, 0, 0, 0);
        p1 = __builtin_amdgcn_mfma_f32_32x32x16_bf16(a1, qf[s], p1, 0, 0, 0);
    }
    const int qrel = qw0 + r32 - k0 - 4 * hi;
    f32x16 c0, c1, lm0, lm1;
    float lb00;
#pragma unroll
    for (int r = 0; r < 16; ++r) {
        { const float z = p0[r], e = ATT_EX2(-__builtin_fabsf(z)), lp = ATT_LG2(1.0f + e); const float mn = __builtin_amdgcn_fmed3f(z, -INFINITY, 0.0f);
          const float lb = mn - lp; lm0[r] = lb - z; c0[r] = lb + carry; if (r == 0) lb00 = lb; }
        { const float z = p1[r], e = ATT_EX2(-__builtin_fabsf(z)), lp = ATT_LG2(1.0f + e); const float mn = __builtin_amdgcn_fmed3f(z, -INFINITY, 0.0f);
          const float lb = mn - lp; lm1[r] = lb - z; c1[r] = lb + carry; }
    }
    if (DIAG) {
#pragma unroll
        for (int r = 0; r < 16; ++r) { lm0[r] = (crowc(r) < qrel) ? lm0[r] : 0.f; lm1[r] = (32 + crowc(r) < qrel) ? lm1[r] : 0.f; }
    }
    const f16x8 L00 = ATT_PACKH8(lm0, 0), L01 = ATT_PACKH8(lm0, 8), L10 = ATT_PACKH8(lm1, 0), L11 = ATT_PACKH8(lm1, 8);
    c0 = __builtin_amdgcn_mfma_f32_32x32x16_f16(Ud[0], L00, c0, 0, 0, 0);
    c1 = __builtin_amdgcn_mfma_f32_32x32x16_f16(Ud[0], L10, c1, 0, 0, 0);
    c0 = __builtin_amdgcn_mfma_f32_32x32x16_f16(Ud[1], L01, c0, 0, 0, 0);
    c1 = __builtin_amdgcn_mfma_f32_32x32x16_f16(Ud[1], L11, c1, 0, 0, 0);
    c0 = __builtin_amdgcn_mfma_f32_32x32x16_f16(ones, L10, c0, 0, 0, 0);
    c0 = __builtin_amdgcn_mfma_f32_32x32x16_f16(ones, L11, c0, 0, 0, 0);
    carry = __shfl((c0[0] - lb00) + lm0[0], r32);
    f32x16 w0, w1;
#pragma unroll
    for (int r = 0; r < 16; ++r) { w0[r] = ATT_EX2(c0[r]); w1[r] = ATT_EX2(c1[r]); }
    if (DIAG) {
#pragma unroll
        for (int r = 0; r < 16; ++r) { w0[r] = (crowc(r) < qrel) ? w0[r] : 0.f; w1[r] = (32 + crowc(r) < qrel) ? w1[r] : 0.f; }
    }
    const bf16x8 W00 = ATT_PACK8(w0, 0), W01 = ATT_PACK8(w0, 8), W10 = ATT_PACK8(w1, 0), W11 = ATT_PACK8(w1, 8);
    const int lane_ = r32 + 32 * hi;
    const LAS unsigned char* vb = lds + voff + (4 * hi + ((lane_ & 15) >> 2)) * 192 + 32 * ((lane_ >> 4) & 1) + 8 * (lane_ & 3);
#define vfrag vfrag<192>
    o0 = __builtin_amdgcn_mfma_f32_32x32x16_bf16(W00, vfrag(vb, 0, 0, 0), o0, 0, 0, 0);
    o1 = __builtin_amdgcn_mfma_f32_32x32x16_bf16(W00, vfrag(vb, 1, 0, 0), o1, 0, 0, 0);
    o0 = __builtin_amdgcn_mfma_f32_32x32x16_bf16(W01, vfrag(vb, 0, 0, 1), o0, 0, 0, 0);
    o1 = __builtin_amdgcn_mfma_f32_32x32x16_bf16(W01, vfrag(vb, 1, 0, 1), o1, 0, 0, 0);
    o0 = __builtin_amdgcn_mfma_f32_32x32x16_bf16(W10, vfrag(vb, 0, 1, 0), o0, 0, 0, 0);
    o1 = __builtin_amdgcn_mfma_f32_32x32x16_bf16(W10, vfrag(vb, 1, 1, 0), o1, 0, 0, 0);
    o0 = __builtin_amdgcn_mfma_f32_32x32x16_bf16(W11, vfrag(vb, 0, 1, 1), o0, 0, 0, 0);
    o1 = __builtin_amdgcn_mfma_f32_32x32x16_bf16(W11, vfrag(vb, 1, 1, 1), o1, 0, 0, 0);
#undef vfrag
}
__device__ __forceinline__ void sb_unit(LAS unsigned char* lds, const bf16_t* PROJ, bf16_t* O, float* SS, int b, int h, int qb) {
    const int tid = threadIdx.x, lane = tid & 63, r32 = lane & 31, hi = lane >> 5, wid = __builtin_amdgcn_readfirstlane(tid >> 6);
    const int q0 = qb * 256, qw0 = q0 + 32 * wid;
    const bf16_t* Qg = PROJ + (size_t)(b * SEQ) * NPROJ + h * 64; const bf16_t* Kg = Qg + 512; const bf16_t* Vg = Qg + 1024;
    bf16x8 qf[4];
#pragma unroll
    for (int s = 0; s < 4; ++s) qf[s] = *(const bf16x8*)(Qg + (size_t)(qw0 + r32) * NPROJ + 16 * s + 8 * hi);
    f16x8 Ud[2], ones;
#pragma unroll
    for (int s2 = 0; s2 < 2; ++s2)
#pragma unroll
        for (int e = 0; e < 8; ++e) Ud[s2][e] = ((16 * s2 + 8 * (e >> 2) + 4 * hi + (e & 3)) > r32) ? (_Float16)1.0f : (_Float16)0.0f;
#pragma unroll
    for (int e = 0; e < 8; ++e) ones[e] = (_Float16)1.0f;
    f32x16 o0 = {}, o1 = {}; float carry = 0.f;
    constexpr int SBB = 21504, SBV = 9216, NS = 6;
    const int T0 = 4 * qb, Tw = T0 + (wid >> 1), nstep = T0 + 4;
    {
        TileRegs<64, 64> P[4];
#pragma unroll
        for (int jj = 0; jj < 4; ++jj) tile_load<64, 64>(P[jj], Kg, NPROJ, Vg, NPROJ, (T0 + jj) * 64, tid);
#pragma unroll
        for (int jj = 0; jj < 4; ++jj) tile_store<64, 64>(P[jj], lds + ((T0 + jj) % NS) * SBB, tid, SBV);
    }
    TileRegs<64, 64> R;
    if (T0 >= 1) tile_load<64, 64>(R, Kg, NPROJ, Vg, NPROJ, (T0 - 1) * 64, tid);
    LAS unsigned* flags = (LAS unsigned*)(lds + FLAG_OFF);
    bool dead = false;
    if (lane == 0) flags[8 + wid] = 0u;
    for (int i = 0; i < nstep; ++i) {
        __syncthreads();
        { const LAS unsigned* fl = flags + ((i + 1) & 1) * 8;
          const unsigned all = fl[0] & fl[1] & fl[2] & fl[3] & fl[4] & fl[5] & fl[6] & fl[7];
          if (all) break; }
        const int tn = T0 - i - 1;
        if (tn >= 0) { tile_store<64, 64>(R, lds + (tn % NS) * SBB, tid, SBV); if (tn >= 1) tile_load<64, 64>(R, Kg, NPROJ, Vg, NPROJ, (tn - 1) * 64, tid); }
        const int T = Tw - i;
        if (T >= 0 && !dead) {
            sb_tile(i == 0, lds + (T % NS) * SBB, SBV, qf, Ud, ones, o0, o1, carry, T * 64, qw0, r32, hi);
            dead = !__any(carry >= -160.f);
        }
        if (lane == 0) flags[(i & 1) * 8 + wid] = (dead || T < 1) ? 1u : 0u;
    }
#pragma unroll
    for (int r = 0; r < 16; ++r) {
        const size_t row = (size_t)b * SEQ + qw0 + crow(r, hi);
        O[row * D + h * 64 + r32] = (bf16_t)f2bf(o0[r]); O[row * D + h * 64 + 32 + r32] = (bf16_t)f2bf(o1[r]);
        float ss = o0[r] * o0[r] + o1[r] * o1[r];
        ss += __shfl_xor(ss, 1); ss += __shfl_xor(ss, 2); ss += __shfl_xor(ss, 4); ss += __shfl_xor(ss, 8); ss += __shfl_xor(ss, 16);
        if (r32 == 0) SS[row * 16 + h] = ss;
    }
}

__device__ __forceinline__ void mla_half(const bool DIAG, const int p, const LAS unsigned char* lds, LAS float* wsf, const bf16x8 (&qf)[12], f32x16 (&o)[4], float& m_run, float& l_run, int k0, int qw0, int r32, int hi) {
    constexpr int KROWB = 400;
    f32x16 p0 = {};
    const LAS unsigned char* kb = lds + (32 * p + r32) * KROWB + hi * 16;
    bf16x8 ka[4];
    ka[0] = *(const LAS bf16x8*)(kb); ka[1] = *(const LAS bf16x8*)(kb + 32); ka[2] = *(const LAS bf16x8*)(kb + 64);
#pragma unroll
    for (int s = 0; s < 12; ++s) {
        if (s + 3 < 12) ka[(s + 3) & 3] = *(const LAS bf16x8*)(kb + (s + 3) * 32);
        __builtin_amdgcn_sched_barrier(0);
        p0 = __builtin_amdgcn_mfma_f32_32x32x16_bf16(ka[s & 3], qf[s], p0, 0, 0, 0);
        __builtin_amdgcn_sched_barrier(0);
    }
    if (DIAG) {
        const int qrel = qw0 + r32 - k0 - 32 * p - 4 * hi;
#pragma unroll
        for (int r = 0; r < 16; ++r) { if (crowc(r) > qrel) p0[r] = -INFINITY; }
    }
    float mt = p0[0];
#pragma unroll
    for (int r = 1; r < 16; ++r) mt = __builtin_fmaxf(mt, p0[r]);
    mt = __builtin_fmaxf(mt, __shfl_xor(mt, 32));
    if (__any(mt > m_run)) {
        const float mn = __builtin_fmaxf(m_run, mt), corr = ATT_EX2(m_run - mn);
        m_run = mn;
        l_run *= corr;
        if (hi == 0) wsf[r32] = corr;
        const LAS float* wsfh = wsf + 4 * hi;
#pragma unroll
        for (int r = 0; r < 16; ++r) { const float f = wsfh[crowc(r)];
#pragma unroll
            for (int db = 0; db < 4; ++db) o[db][r] *= f; }
    }
    float rs = 0.f;
#pragma unroll
    for (int r = 0; r < 16; ++r) { p0[r] = ATT_EX2(p0[r] - m_run); rs += p0[r]; }
    l_run += rs;
    const bf16x8 W0 = ATT_PACK8(p0, 0), W1 = ATT_PACK8(p0, 8);
    const int lane_ = r32 + 32 * hi;
    const LAS unsigned char* vb = lds + KV_OFF + (4 * hi + ((lane_ & 15) >> 2)) * 320 + 32 * ((lane_ >> 4) & 1) + 8 * (lane_ & 3);
    bf16x8 vf[3];
    vf[0] = vfrag<320>(vb, 0, p, 0); vf[1] = vfrag<320>(vb, 0, p, 1);
#pragma unroll
    for (int i = 0; i < 8; ++i) {
        if (i + 2 < 8) vf[(i + 2) % 3] = vfrag<320>(vb, (i + 2) >> 1, p, (i + 2) & 1);
        __builtin_amdgcn_sched_barrier(0);
        o[i >> 1] = __builtin_amdgcn_mfma_f32_32x32x16_bf16((i & 1) ? W1 : W0, vf[i % 3], o[i >> 1], 0, 0, 0);
        __builtin_amdgcn_sched_barrier(0);
    }
}
__device__ __forceinline__ void mla_unit(LAS unsigned char* lds, const bf16_t* QM, const bf16_t* KM, const bf16_t* VM, bf16_t* O, float* SS, int b, int h, int qb) {
    const int tid = threadIdx.x, lane = tid & 63, r32 = lane & 31, hi = lane >> 5, wid = __builtin_amdgcn_readfirstlane(tid >> 6);
    const int q0 = qb * 256, qw0 = q0 + 32 * wid;
    const bf16_t* Qg = QM + ((size_t)(b * SEQ) * 4 + h) * MQK; const bf16_t* Kg = KM + ((size_t)(b * SEQ) * 4 + h) * MQK; const bf16_t* Vg = VM + ((size_t)(b * SEQ) * 4 + h) * MV;
    LAS float* wsf = (LAS float*)(lds + WS_OFF) + wid * 64;
    bf16x8 qf[12];
#pragma unroll
    for (int s = 0; s < 12; ++s) qf[s] = *(const bf16x8*)(Qg + (size_t)(qw0 + r32) * (4 * MQK) + 16 * s + 8 * hi);
    f32x16 o[4] = {{}, {}, {}, {}}; float m_run = -INFINITY, l_run = 0.f;
    const int ntile = (q0 + 256) / 64;
    TileRegs<192, 128> R;
    tile_load<192, 128>(R, Kg, 4 * MQK, Vg, 4 * MV, 0, tid);
    tile_store<192, 128>(R, lds, tid);
    tile_load<192, 128>(R, Kg, 4 * MQK, Vg, 4 * MV, 64, tid);
    for (int t = 0; t < ntile; ++t) {
        __syncthreads();
        if (t + 1 < ntile) { tile_store<192, 128>(R, lds + ((t + 1) & 1) * BUFB, tid); if (t + 2 < ntile) tile_load<192, 128>(R, Kg, 4 * MQK, Vg, 4 * MV, (t + 2) * 64, tid); }
        const int k0 = t * 64;
        const LAS unsigned char* buf = lds + (t & 1) * BUFB;
        if (k0 <= qw0 + 31) {
            mla_half(k0 + 31 > qw0, 0, buf, wsf, qf, o, m_run, l_run, k0, qw0, r32, hi);
            if (k0 + 32 <= qw0 + 31) mla_half(k0 + 63 > qw0, 1, buf, wsf, qf, o, m_run, l_run, k0, qw0, r32, hi);
        }
    }
    const float lt = l_run + __shfl_xor(l_run, 32);
    if (hi == 0) wsf[r32] = 1.0f / lt;
    float f[16];
#pragma unroll
    for (int r = 0; r < 16; ++r) f[r] = wsf[crow(r, hi)];
#pragma unroll
    for (int r = 0; r < 16; ++r) {
        const size_t row = (size_t)b * SEQ + qw0 + crow(r, hi);
        float ss = 0.f;
#pragma unroll
        for (int db = 0; db < 4; ++db) { const float v = o[db][r] * f[r]; O[row * D + 512 + h * 128 + 32 * db + r32] = (bf16_t)f2bf(v); ss += v * v; }
        ss += __shfl_xor(ss, 1); ss += __shfl_xor(ss, 2); ss += __shfl_xor(ss, 4); ss += __shfl_xor(ss, 8); ss += __shfl_xor(ss, 16);
        if (r32 == 0) SS[row * 16 + 8 + h] = ss;
    }
}
}

struct Args { const float* in[21]; float* out; unsigned char* ws; int ph_lo, ph_hi; };

struct Frame {
    LAS unsigned char* lds;
    int wave, G, bid;
    const float *x, *c, *w_ada, *b_ada, *norm_attn, *norm_ffn, *w_in, *q_a_norm, *w_q_up, *kv_a_norm, *w_kv_up, *q_norm, *k_nope_norm, *k_rope_norm,
        *out_norm_sb, *out_norm_mla, *w_out, *w_gate, *w_up, *w_down;
    const int* pos;
    float* out;
    float* mod;
    bf16_t *Win_t, *Wq_t, *Wkv_t, *Wout_t, *Wgu_t, *Wd_t;
    float* SS;
    bf16_t *H, *PROJ, *QM, *KM, *VM, *O, *A2;
    float *COS, *SIN;
};

__device__ __forceinline__ void transpose_item(const float* W, int K, int N, bf16_t* WT, LAS float* scr, int item, int lane, int mode, const float* g0, const float* g1) {
    const int nblk = N / 32, kb = item / nblk, nb = item % nblk, k0 = 64 * kb, n0 = 32 * nb;
    const float nsc = (mode == 0 && n0 < 512) ? 0.18033688011112042f : 1.f;
#pragma unroll 8
    for (int i = 0; i < 32; ++i) {
        const int kk = 2 * i + (lane >> 5), k = k0 + kk;
        float gk = 1.f;
        if (mode == 1 || mode == 2) gk = g0[k];
        if (mode == 3) gk = (k < 512) ? g0[k] : g1[k - 512];
        scr[kk * 33 + (lane & 31)] = __builtin_nontemporal_load(W + (size_t)k * N + n0 + (lane & 31)) * gk * nsc;
    }
    asm volatile("s_waitcnt lgkmcnt(0)" ::: "memory");
    const int c = lane & 7;
#pragma unroll
    for (int j = 0; j < 4; ++j) {
        const int nn = (lane >> 3) + 8 * j, n = n0 + nn;
        int row = n;
        if (mode == 1) row = (n / 192) * 256 + (n % 192);
        if (mode == 4) row = (n / 128) * 256 + (n % 128);
        if (mode == 5) row = (n / 128) * 256 + (n % 128) + 128;
        const LAS float* s = scr + (8 * c) * 33 + nn;
        v4u o; o.x = pk2(s[0 * 33], s[1 * 33]); o.y = pk2(s[2 * 33], s[3 * 33]); o.z = pk2(s[4 * 33], s[5 * 33]); o.w = pk2(s[6 * 33], s[7 * 33]);
        *(v4u*)(WT + (size_t)row * K + k0 + 8 * c) = o;
    }
    asm volatile("s_waitcnt lgkmcnt(0)" ::: "memory");
}

__device__ __forceinline__ void p0_prep(Frame& F) {
    LAS float* sc = (LAS float*)F.lds;
    LAS float* red = (LAS float*)(F.lds + 32768);
    if (F.bid < 192) {
        for (int i = tid_now(); i < 8 * 1024; i += NT) sc[i] = siluf(F.c[i]);
        __syncthreads();
        for (int it = F.bid; it < 192; it += F.G) {
            const int tid = tid_now(), cq = tid & 7, kg = tid >> 3, n0 = it * 32 + 4 * cq;
            f32x4 w4[16];
#pragma unroll
            for (int kk = 0; kk < 16; ++kk) w4[kk] = __builtin_nontemporal_load((const f32x4*)(F.w_ada + (size_t)(kg * 16 + kk) * 6144 + n0));
            f32x4 acc[8];
#pragma unroll
            for (int b = 0; b < 8; ++b) acc[b] = (f32x4){0.f, 0.f, 0.f, 0.f};
#pragma unroll
            for (int kk = 0; kk < 16; ++kk)
#pragma unroll
                for (int b = 0; b < 8; ++b) acc[b] += w4[kk] * sc[b * 1024 + kg * 16 + kk];
#pragma unroll
            for (int b = 0; b < 8; ++b) *(LAS f32x4*)(red + (kg * 8 + b) * 32 + 4 * cq) = acc[b];
            __syncthreads();
            if (tid < 256) {
                const int b = tid >> 5, j = tid & 31, n = it * 32 + j;
                float s = F.b_ada[n];
#pragma unroll 8
                for (int g = 0; g < 64; ++g) s += red[(g * 8 + b) * 32 + j];
                F.mod[b * 6144 + n] = s;
            }
            __syncthreads();
        }
    }
    __syncthreads();
    LAS float* scr = (LAS float*)(F.lds + F.wave * 16384);
    const int gw = F.bid * NW + F.wave, NGW = F.G * NW;
    constexpr int I_IN = (D / 64) * (NPROJ_REAL / 32), I_Q = (QRANK / 64) * (768 / 32), I_KV = (KVRANK / 64) * (1024 / 32), I_O = (D / 64) * (D / 32),
                  I_G = (D / 64) * (FF / 32), I_D = (FF / 64) * (D / 32);
    (void)I_Q; (void)I_KV; (void)I_O;
    {
        const bool split = false;
        const int first = split ? 192 : 0, nb = F.G - first;
        if (F.bid >= first) {
            const int gw2 = (F.bid - first) * NW + F.wave, NGW2 = nb * NW;
            for (int it = gw2; it < I_IN; it += NGW2) transpose_item(F.w_in, D, NPROJ_REAL, F.Win_t, scr, it, lane_now(), 0, nullptr, nullptr);
        }
    }
    {
        const int gt = F.bid * NT + tid_now(), NGT = F.G * NT;
        const v4u z = (v4u){0u, 0u, 0u, 0u};
        for (int i = gt; i < 64 * 1024 / 8; i += NGT) *(v4u*)(F.Win_t + (size_t)NPROJ_REAL * D + (size_t)i * 8) = z;
        for (int i = gt; i < 4 * 64 * 384 / 8; i += NGT) {
            const int h = i / (64 * 384 / 8), r = i % (64 * 384 / 8);
            *(v4u*)(F.Wq_t + (size_t)(h * 256 + 192) * QRANK + (size_t)r * 8) = z;
        }
    }
}


__device__ __forceinline__ void p2_tail_ffn_weights(Frame& F) {
    const int first = (F.G > 64) ? 64 : 0, nb = F.G - first;
    if (F.bid < first) return;
    LAS float* scr = (LAS float*)(F.lds + F.wave * 16384);
    const int gw = (F.bid - first) * NW + F.wave, NGW = nb * NW;
    constexpr int I_G = (D / 64) * (FF / 32), I_D = (FF / 64) * (D / 32), I_Q = (QRANK / 64) * (768 / 32), I_KV = (KVRANK / 64) * (1024 / 32), I_O = (D / 64) * (D / 32);
    for (int it = gw; it < I_Q + I_KV + I_O + 2 * I_G + I_D; it += NGW) {
        int r = it;
        if (r < I_Q) { transpose_item(F.w_q_up, QRANK, 768, F.Wq_t, scr, r, lane_now(), 1, F.q_a_norm, nullptr); continue; } r -= I_Q;
        if (r < I_KV) { transpose_item(F.w_kv_up, KVRANK, 1024, F.Wkv_t, scr, r, lane_now(), 2, F.kv_a_norm, nullptr); continue; } r -= I_KV;
        if (r < I_O) { transpose_item(F.w_out, D, D, F.Wout_t, scr, r, lane_now(), 3, F.out_norm_sb, F.out_norm_mla); continue; } r -= I_O;
        if (r < I_G) { transpose_item(F.w_gate, D, FF, F.Wgu_t, scr, r, lane_now(), 4, nullptr, nullptr); continue; } r -= I_G;
        if (r < I_G) { transpose_item(F.w_up, D, FF, F.Wgu_t, scr, r, lane_now(), 5, nullptr, nullptr); continue; } r -= I_G;
        transpose_item(F.w_down, FF, D, F.Wd_t, scr, r, lane_now(), 6, nullptr, nullptr);
    }
}

__device__ __forceinline__ void p_hnorm(Frame& F, const float* X, const float* g, int ishift, int iscale, bf16_t* Hout) {
    const int vb = (F.G % 8 == 0) ? (F.bid % 8) * (F.G / 8) + F.bid / 8 : F.bid;
    const int gw = vb * NW + F.wave, NGW = F.G * NW, lane = lane_now();
    for (int m0 = gw * 8; m0 < M; m0 += NGW * 8) {
        const int b = m0 / SEQ;
        const float* mb = F.mod + (size_t)b * 6144;
        f32x4 mul[4], add[4];
#pragma unroll
        for (int j = 0; j < 4; ++j) {
            const int col = 8 * lane + 512 * (j >> 1) + 4 * (j & 1);
            mul[j] = *(const f32x4*)(g + col) * (*(const f32x4*)(mb + iscale * 1024 + col) + 1.f);
            add[j] = *(const f32x4*)(mb + ishift * 1024 + col);
        }
#pragma unroll 2
        for (int i = 0; i < 8; ++i) {
            const int m = m0 + i;
            const float* xr = X + (size_t)m * D + 8 * lane;
            f32x4 v[4]; float s = 0.f;
#pragma unroll
            for (int j = 0; j < 4; ++j) { v[j] = __builtin_nontemporal_load((const f32x4*)(xr + 512 * (j >> 1) + 4 * (j & 1))); s += (v[j].x * v[j].x + v[j].y * v[j].y) + (v[j].z * v[j].z + v[j].w * v[j].w); }
            const float rstd = rsqrtf(wave_sum(s) * (1.f / D) + EPS);
            bf16_t* orow = Hout + (size_t)m * D + 8 * lane;
#pragma unroll
            for (int jj = 0; jj < 2; ++jj) {
                const f32x4 ha = v[2 * jj] * rstd * mul[2 * jj] + add[2 * jj], hb = v[2 * jj + 1] * rstd * mul[2 * jj + 1] + add[2 * jj + 1];
                v4u w; w.x = pk2(ha.x, ha.y); w.y = pk2(ha.z, ha.w); w.z = pk2(hb.x, hb.y); w.w = pk2(hb.z, hb.w);
                *(v4u*)(orow + 512 * jj) = w;
            }
        }
    }
}

template <bool DUAL, class Epi>
__device__ __forceinline__ void ngemm(Frame& F, const bf16_t* A, int lda, const bf16_t* Bt, int K, int N, const Epi& epi) {
    const long total = (long)(M / 4) * N;
    for (long idx = (long)F.bid * NT + tid_now(); idx < total; idx += (long)F.G * NT) {
        const int n = (int)(idx % N), m0 = (int)(idx / N) * 4;
        const int r0 = DUAL ? (n / 128) * 256 + (n % 128) : n;
        const v4u* b0 = (const v4u*)(Bt + (size_t)r0 * K);
        const v4u* b1 = (const v4u*)(Bt + (size_t)(r0 + 128) * K);
        const v4u* a0 = (const v4u*)(A + (size_t)m0 * lda);
        float acc0 = 0.f, acc1 = 0.f, acc2 = 0.f, acc3 = 0.f, bcc0 = 0.f, bcc1 = 0.f, bcc2 = 0.f, bcc3 = 0.f;
        for (int k8 = 0; k8 < K / 8; ++k8) {
            const v4u bv = b0[k8];
            const v4u av0 = a0[k8], av1 = a0[k8 + lda / 8], av2 = a0[k8 + 2 * (lda / 8)], av3 = a0[k8 + 3 * (lda / 8)];
            acc0 += dot8(av0, bv); acc1 += dot8(av1, bv); acc2 += dot8(av2, bv); acc3 += dot8(av3, bv);
            if (DUAL) { const v4u bw = b1[k8]; bcc0 += dot8(av0, bw); bcc1 += dot8(av1, bw); bcc2 += dot8(av2, bw); bcc3 += dot8(av3, bw); }
        }
        epi(m0, n, acc0, bcc0); epi(m0 + 1, n, acc1, bcc1); epi(m0 + 2, n, acc2, bcc2); epi(m0 + 3, n, acc3, bcc3);
    }
}
struct NEpiBf16 { bf16_t* O; int ldc; __device__ __forceinline__ void operator()(int m, int n, float a, float) const { O[(size_t)m * ldc + n] = (bf16_t)f2bf(a); } };
struct NEpiF32 { float* O; int ldc; __device__ __forceinline__ void operator()(int m, int n, float a, float) const { O[(size_t)m * ldc + n] = a; } };
struct NEpiRes { const float* base; float* out; const float* mod; int igate;
    __device__ __forceinline__ void operator()(int m, int n, float a, float) const { const int b = m / SEQ; out[(size_t)m * D + n] = base[(size_t)m * D + n] + mod[b * 6144 + igate * 1024 + n] * a; } };
struct NEpiSwiglu { bf16_t* O; __device__ __forceinline__ void operator()(int m, int n, float g, float u) const { O[(size_t)m * FF + n] = (bf16_t)f2bf(siluf(g) * u); } };

__device__ __forceinline__ void rope_freq_cs(int i, int pos, float& cs, float& sn) {
    const float freq = 1.0f / powf(10000.0f, (float)i * (1.0f / 32.0f));
    const float ang = (float)pos * freq;
    sincosf(ang, &sn, &cs);
}
__device__ __forceinline__ void p_qpost(Frame& F, const float* tmp) {
    const int gw = F.bid * NW + F.wave, NGW = F.G * NW, lane = lane_now();
    for (int m = gw; m < M; m += NGW) {
        const bf16_t* pr = F.PROJ + (size_t)m * NPROJ + C_CQ;
        float s = 0.f;
#pragma unroll
        for (int i = 0; i < 6; ++i) { const float v = bf2f(pr[lane + 64 * i]); s += v * v; }
        const float rstd_cq = rsqrtf(wave_sum(s) * (1.f / QRANK) + EPS);
        const int pos = F.pos[m];
        float cs, sn; rope_freq_cs(lane & 31, pos, cs, sn);
#pragma unroll
        for (int h = 0; h < 4; ++h) {
            float q[3]; float ss = 0.f;
#pragma unroll
            for (int i = 0; i < 3; ++i) { q[i] = tmp[(size_t)m * 1024 + h * 256 + lane + 64 * i] * rstd_cq; ss += q[i] * q[i]; }
            const float rstd = rsqrtf(wave_sum(ss) * (1.f / MQK) + EPS);
#pragma unroll
            for (int i = 0; i < 3; ++i) q[i] = q[i] * rstd * F.q_norm[lane + 64 * i];
            const float partner = __shfl_xor(q[2], 32);
            q[2] = (lane < 32) ? (q[2] * cs - partner * sn) : (q[2] * cs + partner * sn);
            const float qs = 0.10411754714f;
#pragma unroll
            for (int i = 0; i < 3; ++i) F.QM[((size_t)m * 4 + h) * MQK + lane + 64 * i] = (bf16_t)f2bf(q[i] * qs);
        }
    }
}
__device__ __forceinline__ void p_kvpost(Frame& F, const float* tmp) {
    const int gw = F.bid * NW + F.wave, NGW = F.G * NW, lane = lane_now();
    for (int m = gw; m < M; m += NGW) {
        const bf16_t* pr = F.PROJ + (size_t)m * NPROJ;
        float s = 0.f;
#pragma unroll
        for (int i = 0; i < 4; ++i) { const float v = bf2f(pr[C_CKV + lane + 64 * i]); s += v * v; }
        const float rstd_ckv = rsqrtf(wave_sum(s) * (1.f / KVRANK) + EPS);
        const int pos = F.pos[m];
        float cs, sn; rope_freq_cs(lane & 31, pos, cs, sn);
        float kr = bf2f(pr[C_KR + lane]);
        const float rstd_kr = rsqrtf(wave_sum(kr * kr) * (1.f / MROPE) + EPS);
        kr = kr * rstd_kr * F.k_rope_norm[lane];
        const float partner = __shfl_xor(kr, 32);
        kr = (lane < 32) ? (kr * cs - partner * sn) : (kr * cs + partner * sn);
#pragma unroll
        for (int h = 0; h < 4; ++h) {
            float k[2], v[2]; float ss = 0.f;
#pragma unroll
            for (int i = 0; i < 2; ++i) { k[i] = tmp[(size_t)m * 1024 + h * 256 + lane + 64 * i] * rstd_ckv; ss += k[i] * k[i]; v[i] = tmp[(size_t)m * 1024 + h * 256 + 128 + lane + 64 * i] * rstd_ckv; }
            const float rstd = rsqrtf(wave_sum(ss) * (1.f / MNOPE) + EPS);
#pragma unroll
            for (int i = 0; i < 2; ++i) {
                F.KM[((size_t)m * 4 + h) * MQK + lane + 64 * i] = (bf16_t)f2bf(k[i] * rstd * F.k_nope_norm[lane + 64 * i]);
                F.VM[((size_t)m * 4 + h) * MV + lane + 64 * i] = (bf16_t)f2bf(v[i]);
            }
            F.KM[((size_t)m * 4 + h) * MQK + 128 + lane] = (bf16_t)f2bf(kr);
        }
    }
}


__device__ __forceinline__ void p_rope_table(Frame& F, int first_block, int nblocks) {
    if (F.bid < first_block || nblocks <= 0) return;
    const int gt = (F.bid - first_block) * NT + tid_now(), NGT = nblocks * NT;
    for (int idx = gt; idx < M * 32; idx += NGT) { float cs, sn; rope_freq_cs(idx & 31, F.pos[idx >> 5], cs, sn); F.COS[idx] = cs; F.SIN[idx] = sn; }
}
__device__ __forceinline__ float ssq8(v4u a) {
    float s = 0.f;
    { const float lo = bf2f(a.x & 0xffffu), hi = __uint_as_float(a.x & 0xffff0000u); s += lo * lo + hi * hi; }
    { const float lo = bf2f(a.y & 0xffffu), hi = __uint_as_float(a.y & 0xffff0000u); s += lo * lo + hi * hi; }
    { const float lo = bf2f(a.z & 0xffffu), hi = __uint_as_float(a.z & 0xffff0000u); s += lo * lo + hi * hi; }
    { const float lo = bf2f(a.w & 0xffffu), hi = __uint_as_float(a.w & 0xffff0000u); s += lo * lo + hi * hi; }
    return s;
}
__device__ __forceinline__ void p3_stats(Frame& F, int pm, int pn) {
    LAS float* st = (LAS float*)(F.lds + pg8::ST_OFF);
    const int lane = lane_now(), l8 = lane & 7;
    f32x4 gk[2];
    gk[0] = *(const f32x4*)(F.k_rope_norm + 8 * l8); gk[1] = *(const f32x4*)(F.k_rope_norm + 8 * l8 + 4);
#pragma unroll 2
    for (int p = 0; p < 4; ++p) {
        const int r = F.wave * 32 + p * 8 + (lane >> 3); const size_t row = (size_t)pm * 256 + r;
        const bf16_t* pr = F.PROJ + row * NPROJ + C_CQ + l8 * 8;
        v4u v[11];
#pragma unroll
        for (int i = 0; i < 11; ++i) v[i] = *(const v4u*)(pr + 64 * i);
        const int i0 = (8 * l8) & 31;
        const f32x4 cs0 = *(const f32x4*)(F.COS + row * 32 + i0), cs1 = *(const f32x4*)(F.COS + row * 32 + i0 + 4);
        const f32x4 sn0 = *(const f32x4*)(F.SIN + row * 32 + i0), sn1 = *(const f32x4*)(F.SIN + row * 32 + i0 + 4);
        float s_cq = 0.f, s_ckv = 0.f;
#pragma unroll
        for (int i = 0; i < 6; ++i) s_cq += ssq8(v[i]);
#pragma unroll
        for (int i = 6; i < 10; ++i) s_ckv += ssq8(v[i]);
        float s_kr = ssq8(v[10]);
        s_cq += __shfl_xor(s_cq, 1); s_ckv += __shfl_xor(s_ckv, 1); s_kr += __shfl_xor(s_kr, 1);
        s_cq += __shfl_xor(s_cq, 2); s_ckv += __shfl_xor(s_ckv, 2); s_kr += __shfl_xor(s_kr, 2);
        s_cq += __shfl_xor(s_cq, 4); s_ckv += __shfl_xor(s_ckv, 4); s_kr += __shfl_xor(s_kr, 4);
        if (l8 == 0) { st[r] = rsqrtf(s_cq * (1.f / QRANK) + EPS); st[256 + r] = rsqrtf(s_ckv * (1.f / KVRANK) + EPS); }
        const float rk = rsqrtf(s_kr * (1.f / MROPE) + EPS);
        const v4u b = v[10];
        float x[8];
        x[0] = bf2f(b.x & 0xffffu) * rk * gk[0][0]; x[1] = __uint_as_float(b.x & 0xffff0000u) * rk * gk[0][1];
        x[2] = bf2f(b.y & 0xffffu) * rk * gk[0][2]; x[3] = __uint_as_float(b.y & 0xffff0000u) * rk * gk[0][3];
        x[4] = bf2f(b.z & 0xffffu) * rk * gk[1][0]; x[5] = __uint_as_float(b.z & 0xffff0000u) * rk * gk[1][1];
        x[6] = bf2f(b.w & 0xffffu) * rk * gk[1][2]; x[7] = __uint_as_float(b.w & 0xffff0000u) * rk * gk[1][3];
        float y[8];
#pragma unroll
        for (int e = 0; e < 8; ++e) { const float part = __shfl_xor(x[e], 4); const float cs = (e < 4) ? cs0[e & 3] : cs1[e & 3], sn = (e < 4) ? sn0[e & 3] : sn1[e & 3];
            y[e] = (l8 < 4) ? (x[e] * cs - part * sn) : (x[e] * cs + part * sn); }
        v4u w; w.x = pk2(y[0], y[1]); w.y = pk2(y[2], y[3]); w.z = pk2(y[4], y[5]); w.w = pk2(y[6], y[7]);
        *(v4u*)(F.KM + (row * 4 + pn) * MQK + MNOPE + 8 * l8) = w;
    }
}
__device__ __forceinline__ void p3_mla_up(Frame& F) {
    const int v = (F.G % 8 == 0) ? (F.bid % 8) * (F.G / 8) + F.bid / 8 : F.bid;
    if (v < 256) {
        const int pm = v >> 2, pn = v & 3;
        __syncthreads();
        p3_stats(F, pm, pn);
        __syncthreads();
        const pg8::OneUnit S{pm, pn};
        { pg8::Gemm g{F.PROJ + C_CQ, F.Wq_t, M, 1024, QRANK, NPROJ};
          pg8::gemm_phase<pg8::EpiQ, pg8::OneUnit, false>(F.lds, g, S, pg8::EpiQ{F.QM, F.q_norm, F.COS, F.SIN}); }
        { pg8::Gemm g{F.PROJ + C_CKV, F.Wkv_t, M, 1024, KVRANK, NPROJ};
          pg8::gemm_phase<pg8::EpiKV, pg8::OneUnit, false>(F.lds, g, S, pg8::EpiKV{F.KM, F.VM, F.k_nope_norm}); }
    }
}

__device__ __forceinline__ void p_attn_naive(Frame& F) {
    const int gw = F.bid * NW + F.wave, NGW = F.G * NW, lane = lane_now();
    for (int it = gw; it < BATCH * SBH * SEQ; it += NGW) {
        const int t = it % SEQ, h = (it / SEQ) % SBH, b = it / (SEQ * SBH);
        const size_t row = (size_t)b * SEQ + t;
        const float q = bf2f(F.PROJ[row * NPROJ + h * 64 + lane]);
        float accl = 0.f, o = 0.f;
        for (int s = t - 1; s >= 0; --s) {
            const bf16_t* kr = F.PROJ + ((size_t)b * SEQ + s) * NPROJ + h * 64 + lane;
            const float z = wave_sum(q * bf2f(kr[512])) * 0.6931471805599453f;
            const float lb = logsig(z);
            const float w = expf(lb + accl);
            o += w * bf2f(kr[1024]);
            accl += lb - z;
        }
        F.O[row * D + h * 64 + lane] = (bf16_t)f2bf(o);
        const float ss = wave_sum(o * o);
        if (lane == 0) F.SS[row * 16 + h] = ss;
    }
    for (int it = gw; it < BATCH * MH * SEQ; it += NGW) {
        const int t = it % SEQ, h = (it / SEQ) % MH, b = it / (SEQ * MH);
        const size_t row = (size_t)b * SEQ + t;
        float q[3];
#pragma unroll
        for (int i = 0; i < 3; ++i) q[i] = bf2f(F.QM[(row * 4 + h) * MQK + lane + 64 * i]);
        float mx = -INFINITY, l = 0.f, o0 = 0.f, o1 = 0.f;
        for (int s = 0; s <= t; ++s) {
            const size_t kr = ((size_t)b * SEQ + s) * 4 + h;
            float d = 0.f;
#pragma unroll
            for (int i = 0; i < 3; ++i) d += q[i] * bf2f(F.KM[kr * MQK + lane + 64 * i]);
            const float z = wave_sum(d);
            const float mn = fmaxf(mx, z), corr = exp2f(mx - mn), p = exp2f(z - mn);
            l = l * corr + p;
            o0 = o0 * corr + p * bf2f(F.VM[kr * MV + lane]);
            o1 = o1 * corr + p * bf2f(F.VM[kr * MV + 64 + lane]);
            mx = mn;
        }
        o0 /= l; o1 /= l;
        F.O[row * D + 512 + h * 128 + lane] = (bf16_t)f2bf(o0);
        F.O[row * D + 512 + h * 128 + 64 + lane] = (bf16_t)f2bf(o1);
        const float ss = wave_sum(o0 * o0 + o1 * o1);
        if (lane == 0) F.SS[row * 16 + 8 + h] = ss;
    }
}

__device__ __forceinline__ void p_attn_mla(Frame& F, unsigned* qctr) {
    LAS unsigned* slot = (LAS unsigned*)(F.lds + att::SLOT_OFF);
    if (F.G == 256) {
        const int x = F.bid & 7, idx = F.bid >> 3, bh = 4 * x + (idx >> 3), qb = 7 - (idx & 7);
        __syncthreads();
        att::mla_unit(F.lds, F.QM, F.KM, F.VM, F.O, F.SS, bh >> 2, bh & 3, qb);
        return;
    }
    for (;;) {
        __syncthreads();
        if (tid_now() == 0) *slot = atomicAdd(qctr, 1u);
        __syncthreads();
        const unsigned u = *slot;
        if (u >= 256u) break;
        const int r = (int)u & 31, qb = 7 - ((int)u >> 5);
        att::mla_unit(F.lds, F.QM, F.KM, F.VM, F.O, F.SS, r >> 2, r & 3, qb);
    }
}
__device__ __forceinline__ void p_attn_sb(Frame& F, unsigned* qctr) {
    LAS unsigned* slot = (LAS unsigned*)(F.lds + att::SLOT_OFF);
    const bool xl = (F.G == 256);
    const int x = F.bid & 7;
    unsigned* ctr = xl ? qctr + 64 * (1 + x) : qctr;
    const unsigned nunits = xl ? 64u : 512u;
    for (;;) {
        __syncthreads();
        if (tid_now() == 0) *slot = atomicAdd(ctr, 1u);
        __syncthreads();
        const unsigned u = *slot;
        if (u >= nunits) break;
        int bh, qb;
        if (xl) { bh = 8 * x + ((int)u & 7); qb = 7 - ((int)u >> 3); } else { bh = (int)u & 63; qb = 7 - ((int)u >> 6); }
        att::sb_unit(F.lds, F.PROJ, F.O, F.SS, bh >> 3, bh & 7, qb);
    }
}
__device__ __forceinline__ void p_mixnorm(Frame& F, bf16_t* Hout) {
    const int gw = F.bid * NW + F.wave, NGW = F.G * NW, lane = lane_now();
    for (int m = gw; m < M; m += NGW) {
        float s0 = 0.f, s1 = 0.f;
#pragma unroll
        for (int h = 0; h < 8; ++h) s0 += F.SS[(size_t)m * 16 + h];
#pragma unroll
        for (int h = 0; h < 4; ++h) s1 += F.SS[(size_t)m * 16 + 8 + h];
        const float r0 = rsqrtf(s0 * (1.f / 512) + EPS), r1 = rsqrtf(s1 * (1.f / 512) + EPS);
#pragma unroll
        for (int i = 0; i < 16; ++i) {
            const int col = lane + 64 * i;
            Hout[(size_t)m * D + col] = (bf16_t)f2bf(bf2f(F.O[(size_t)m * D + col]) * (col < 512 ? r0 : r1));
        }
    }
}


#define XB_TMO      128
#define XB_XCNT(j)  (256  + 64 * (j))
#define XB_XSUB(j)  (1280 + 64 * (j))
#define XB_XGEN(j)  (2304 + 64 * (j))
#define XB_TOP      3328
#define XB_TOPGEN   3392
#define XCD_BAR_WORDS 3456
#define XB_SPIN_CAP (1u << 18)
__device__ __forceinline__ unsigned xb_ld(unsigned* p)              { return __hip_atomic_load(p, __ATOMIC_RELAXED, __HIP_MEMORY_SCOPE_AGENT); }
__device__ __forceinline__ unsigned xb_add(unsigned* p, unsigned v) { return __hip_atomic_fetch_add(p, v, __ATOMIC_RELAXED, __HIP_MEMORY_SCOPE_AGENT); }
__device__ __forceinline__ unsigned xb_xcc_id() { return (unsigned)__builtin_amdgcn_s_getreg((3 << 11) | 20) & 0xFu; }
#define XB_SPIN(cond, bar) do { unsigned _sp = 0; while (cond) { __builtin_amdgcn_s_sleep(1); \
    if ((++_sp & 255u) == 0u) { if (xb_ld(&(bar)[XB_TMO])) break; if (_sp > XB_SPIN_CAP) { atomicAdd(&(bar)[XB_TMO], 1u); break; } } } } while (0)
struct XcdBarrier { unsigned* bar; unsigned x; volatile LAS unsigned* st; };
__device__ __forceinline__ XcdBarrier xcd_barrier_post(unsigned* bar, volatile LAS unsigned* st) {
    XcdBarrier b; b.bar = bar; b.x = xb_xcc_id(); b.st = st;
    if (threadIdx.x == 0) (void)xb_add(&bar[XB_XCNT(b.x)], 1u);
    return b;
}
__device__ __forceinline__ void xcd_barrier_complete(unsigned* bar, unsigned x, unsigned& nloc, unsigned& nx) {
    const unsigned G = gridDim.x * gridDim.y * gridDim.z;
    unsigned sum, cnt, mine, sp = 0u;
    for (;;) {
        sum = 0u; cnt = 0u; mine = 0u;
#pragma unroll
        for (unsigned j = 0; j < 16; ++j) { const unsigned c = xb_ld(&bar[XB_XCNT(j)]); sum += c; cnt += (c > 0u) ? 1u : 0u; mine = (j == x) ? c : mine; }
        if (sum == G) break;
        __builtin_amdgcn_s_sleep(1);
        if ((++sp & 255u) == 0u) { if (xb_ld(&bar[XB_TMO])) break; if (sp > XB_SPIN_CAP) { atomicAdd(&bar[XB_TMO], 1u); break; } }
    }
    nloc = mine > 0u ? mine : 1u; nx = cnt > 0u ? cnt : 1u;
}
__device__ __forceinline__ void xcd_barrier(const XcdBarrier& b) {
    asm volatile("s_waitcnt vmcnt(0)" ::: "memory");
    __syncthreads();
    if (threadIdx.x == 0) {
        unsigned* bar = b.bar;
        __builtin_amdgcn_s_waitcnt(0);
        unsigned nloc = b.st[0], nx = b.st[1];
        if (nloc == 0u) { xcd_barrier_complete(bar, b.x, nloc, nx); b.st[0] = nloc; b.st[1] = nx; }
        const unsigned old = xb_add(&bar[XB_XSUB(b.x)], 1u);
        const unsigned gen = old / nloc;
        if (old + 1u == (gen + 1u) * nloc) {
            __builtin_amdgcn_fence(__ATOMIC_RELEASE, "agent");
            asm volatile("s_waitcnt vmcnt(0)" ::: "memory");
            const unsigned og = xb_add(&bar[XB_TOP], 1u);
            const unsigned tg = og / nx;
            if (og + 1u == (tg + 1u) * nx) xb_add(&bar[XB_TOPGEN], 1u);
            else XB_SPIN(xb_ld(&bar[XB_TOPGEN]) == tg, bar);
            __builtin_amdgcn_fence(__ATOMIC_ACQUIRE, "agent");
            xb_add(&bar[XB_XGEN(b.x)], 1u);
            asm volatile("s_waitcnt vmcnt(0)" ::: "memory");
        } else {
            XB_SPIN(xb_ld(&bar[XB_XGEN(b.x)]) == gen, bar);
            __builtin_amdgcn_fence(__ATOMIC_ACQUIRE, "agent");
            asm volatile("s_waitcnt vmcnt(0)" ::: "memory");
        }
    }
    __syncthreads();
}

constexpr int NPHASE = 9;
__global__ void __launch_bounds__(NT, 2) mega(Args args) {
    extern __shared__ __attribute__((aligned(16))) unsigned char lds[];
    cg::grid_group grid = cg::this_grid();
    Frame F;
    F.lds = (LAS unsigned char*)lds;
    F.wave = __builtin_amdgcn_readfirstlane((int)threadIdx.x >> 6); F.G = gridDim.x; F.bid = blockIdx.x;
    F.x = args.in[0]; F.c = args.in[1]; F.pos = (const int*)args.in[2]; F.w_ada = args.in[3]; F.b_ada = args.in[4]; F.norm_attn = args.in[5]; F.norm_ffn = args.in[6];
    F.w_in = args.in[7]; F.q_a_norm = args.in[8]; F.w_q_up = args.in[9]; F.kv_a_norm = args.in[10]; F.w_kv_up = args.in[11]; F.q_norm = args.in[12];
    F.k_nope_norm = args.in[13]; F.k_rope_norm = args.in[14]; F.out_norm_sb = args.in[15]; F.out_norm_mla = args.in[16]; F.w_out = args.in[17];
    F.w_gate = args.in[18]; F.w_up = args.in[19]; F.w_down = args.in[20];
    F.out = args.out;
    unsigned char* ws = args.ws;
    F.mod = (float*)(ws + WS_MOD);
    F.Win_t = (bf16_t*)(ws + WS_WIN); F.Wq_t = (bf16_t*)(ws + WS_WQ); F.Wkv_t = (bf16_t*)(ws + WS_WKV); F.Wout_t = (bf16_t*)(ws + WS_WOUT);
    F.Wgu_t = (bf16_t*)(ws + WS_WGU); F.Wd_t = (bf16_t*)(ws + WS_WD);
    F.SS = (float*)(ws + WS_SS); F.H = (bf16_t*)(ws + WS_H); F.PROJ = (bf16_t*)(ws + WS_PROJ); F.QM = (bf16_t*)(ws + WS_QM); F.KM = (bf16_t*)(ws + WS_KM);
    F.VM = (bf16_t*)(ws + WS_VM); F.O = (bf16_t*)(ws + WS_O); F.A2 = (bf16_t*)(ws + WS_A2);
    F.COS = (float*)(ws + WS_COS); F.SIN = (float*)(ws + WS_SIN);

    const int lo = args.ph_lo, hi = args.ph_hi;
#define IN(k) (lo <= (k) && (k) < hi)
    volatile LAS unsigned* MISC = (volatile LAS unsigned*)(F.lds + MISC_OFF);
    if (tid_now() < 16) MISC[tid_now()] = 0u;
    __syncthreads();
    const XcdBarrier bar = xcd_barrier_post((unsigned*)(ws + WS_CTL), MISC + 8);
    if (lo < 0) grid.sync();
#define SEAM(k) do { if ((k) + 1 < hi) xcd_barrier(bar); } while (0)
    if (IN(0)) { p0_prep(F); SEAM(0); }
    if (IN(1)) { p_hnorm(F, F.x, F.norm_attn, 0, 1, F.H); SEAM(1); }
    if (IN(2)) { pg8::Gemm g{F.H, F.Win_t, M, NPROJ, D, D}; pg8::StaticOrder S; S.init(M, NPROJ, F.G, F.bid); pg8::gemm_phase<pg8::EpiBf16, pg8::StaticOrder, true>(F.lds, g, S, pg8::EpiBf16{F.PROJ, NPROJ}); p2_tail_ffn_weights(F); if (F.G > 64) p_rope_table(F, 64, F.G - 64); else p_rope_table(F, 0, F.G); SEAM(2); }
    if (IN(3)) { p3_mla_up(F); SEAM(3); }
    if (IN(4)) { unsigned* qc = (unsigned*)((unsigned char*)F.mod + WS_QC); p_attn_mla(F, qc); p_attn_sb(F, qc + 64); SEAM(4); }
    if (IN(5)) {
        pg8::Gemm g{F.O, F.Wout_t, M, D, D, D}; pg8::StaticOrder S; S.init(M, D, F.G, F.bid);
        pg8::Unit u0; u0.pm = 0; u0.pn = 0; (void)S.next(0, u0);
        LAS float* tw = (LAS float*)(F.lds + pg8::ST_OFF);
        { const int t = tid_now();
          if (t < 256) { const float* ss = F.SS + (size_t)(u0.pm * 256 + t) * 16;
              const f32x4 a = *(const f32x4*)ss, b = *(const f32x4*)(ss + 4), c = *(const f32x4*)(ss + 8);
              const float ssb = ((a[0] + a[1]) + (a[2] + a[3])) + ((b[0] + b[1]) + (b[2] + b[3])), smla = (c[0] + c[1]) + (c[2] + c[3]);
              tw[t] = sqrtf((smla * (1.f / 512) + EPS) / (ssb * (1.f / 512) + EPS)); tw[256 + t] = rsqrtf(smla * (1.f / 512) + EPS); } }
        __syncthreads();
        pg8::gemm_phase<pg8::EpiResNorm, pg8::StaticOrder, false>(F.lds, g, S, pg8::EpiResNorm{F.x, F.out, F.mod, tw, F.norm_ffn, F.H, (unsigned*)((unsigned char*)F.mod + WS_XBUF), (unsigned*)((unsigned char*)F.mod + WS_PCNT)});
        SEAM(5); }
    if (IN(7)) { pg8::Gemm g{F.H, F.Wgu_t, M, 2 * FF, D, D}; pg8::StaticOrder S; S.init(M, 2 * FF, F.G, F.bid); pg8::gemm_phase<pg8::EpiSwiglu, pg8::StaticOrder, true>(F.lds, g, S, pg8::EpiSwiglu{F.A2, FF}); SEAM(7); }
    if (IN(8)) { pg8::Gemm g{F.A2, F.Wd_t, M, D, FF, FF}; pg8::StaticOrder S; S.init(M, D, F.G, F.bid); pg8::gemm_phase<pg8::EpiRes, pg8::StaticOrder, true>(F.lds, g, S, pg8::EpiRes{F.out, F.out, F.mod + 5 * 1024}); }
#undef IN
#undef SEAM
}

extern "C" void kernel_launch(void* const* d_in, const int* in_sizes, int n_in, void* d_out, int out_size, void* d_ws, size_t ws_size, hipStream_t stream) {
    static int grid = 0;
    if (grid == 0) {
        if (n_in != 21 || out_size != M * D || ws_size < WS_END) { fprintf(stderr, "kernel_launch: unexpected shapes (n_in %d out %d ws %zu)\n", n_in, out_size, ws_size); grid = -1; return; }
        int dev = 0, cus = 0, per_cu = 0;
        hipGetDevice(&dev);
        hipDeviceGetAttribute(&cus, hipDeviceAttributeMultiprocessorCount, dev);
        if (hipFuncSetAttribute((const void*)mega, hipFuncAttributeMaxDynamicSharedMemorySize, LDS_BYTES) != hipSuccess) { fprintf(stderr, "kernel_launch: hipFuncSetAttribute failed\n"); grid = -1; return; }
        if (hipOccupancyMaxActiveBlocksPerMultiprocessor(&per_cu, (const void*)mega, NT, LDS_BYTES) != hipSuccess || per_cu < 1) { fprintf(stderr, "kernel_launch: occupancy query says %d\n", per_cu); per_cu = 1; }
        (void)hipGetLastError();
        if (cus < 256) { fprintf(stderr, "kernel_launch: needs >= 256 CUs (got %d)\n", cus); grid = -1; return; }
        grid = 256;
    }
    if (grid < 0) return;
    if (hipMemsetAsync((char*)d_ws + WS_CTL, 0, CTL_ZERO_BYTES, stream) != hipSuccess) { fprintf(stderr, "kernel_launch: hipMemsetAsync failed\n"); return; }
    Args a{};
    for (int i = 0; i < 21; ++i) a.in[i] = (const float*)d_in[i];
    a.out = (float*)d_out; a.ws = (unsigned char*)d_ws; a.ph_lo = 0; a.ph_hi = NPHASE;
    void* params[] = {&a};
    hipError_t e = hipLaunchCooperativeKernel((const void*)mega, dim3(grid), dim3(NT), params, LDS_BYTES, stream);
    if (e != hipSuccess) fprintf(stderr, "kernel_launch: cooperative launch failed: %s (grid %d)\n", hipGetErrorString(e), grid);
}
```

```cpp
#include <hip/hip_runtime.h>
#include <hip/hip_cooperative_groups.h>
#include <cstdio>
#include <cstdint>
namespace cg = cooperative_groups;

#define LAS __attribute__((address_space(3)))
typedef unsigned short bf16_t;
typedef unsigned v4u __attribute__((ext_vector_type(4)));
typedef float f32x4 __attribute__((ext_vector_type(4)));

constexpr int BATCH = 8, SEQ = 2048, D = 1024, M = BATCH * SEQ;
constexpr int SBH = 8, SBD = 64, SBW = 512;
constexpr int MH = 4, MNOPE = 128, MROPE = 64, MQK = 192, MV = 128, QRANK = 384, KVRANK = 256;
constexpr int NPROJ_REAL = 2240, NPROJ = 2304;
constexpr int C_CQ = 1536, C_CKV = 1920, C_KR = 2176;
constexpr int FF = 2816;
constexpr float EPS = 1e-6f;
constexpr int NW = 8, NT = NW * 64;

constexpr size_t MiB = 1u << 20;
constexpr size_t WS_MOD = 0, WS_WIN = 1 * MiB, WS_WQ = 6 * MiB, WS_WKV = 7 * MiB, WS_WOUT = 8 * MiB, WS_WGU = 10 * MiB, WS_WD = 21 * MiB;
constexpr size_t WS_SS = 27 * MiB, WS_H = 28 * MiB, WS_PROJ = 60 * MiB, WS_QM = 132 * MiB, WS_KM = 156 * MiB, WS_VM = 180 * MiB, WS_O = 196 * MiB;
constexpr size_t WS_A2 = 60 * MiB, WS_COS = 228 * MiB, WS_SIN = 230 * MiB, WS_END = 232 * MiB;
constexpr int LDS_BYTES = 147456, MISC_OFF = 135168;
constexpr size_t WS_CTL = 256 * 1024, WS_QC = WS_CTL + 16 * 1024, WS_PCNT = WS_CTL + 24 * 1024, CTL_ZERO_BYTES = 40 * 1024, WS_XBUF = 512 * 1024;

__device__ __forceinline__ float bf2f(unsigned v) { return __uint_as_float(v << 16); }
__device__ __forceinline__ unsigned f2bf(float f) { unsigned u = __float_as_uint(f); return (u + 0x7fffu + ((u >> 16) & 1u)) >> 16; }
__device__ __forceinline__ unsigned pk2(float lo, float hi) { return f2bf(lo) | (f2bf(hi) << 16); }
__device__ __forceinline__ float wave_sum(float v) {
#pragma unroll
    for (int o = 1; o < 64; o <<= 1) v += __shfl_xor(v, o);
    return v;
}
__device__ __forceinline__ float wave_max(float v) {
#pragma unroll
    for (int o = 1; o < 64; o <<= 1) v = fmaxf(v, __shfl_xor(v, o));
    return v;
}
__device__ __forceinline__ float siluf(float v) { return v / (1.f + expf(-v)); }
__device__ __forceinline__ float logsig(float z) { return fminf(z, 0.f) - log1pf(expf(-fabsf(z))); }
__device__ __forceinline__ float dot8(v4u a, v4u b) {
    float s = 0.f;
    s += bf2f(a.x & 0xffffu) * bf2f(b.x & 0xffffu); s += __uint_as_float(a.x & 0xffff0000u) * __uint_as_float(b.x & 0xffff0000u);
    s += bf2f(a.y & 0xffffu) * bf2f(b.y & 0xffffu); s += __uint_as_float(a.y & 0xffff0000u) * __uint_as_float(b.y & 0xffff0000u);
    s += bf2f(a.z & 0xffffu) * bf2f(b.z & 0xffffu); s += __uint_as_float(a.z & 0xffff0000u) * __uint_as_float(b.z & 0xffff0000u);
    s += bf2f(a.w & 0xffffu) * bf2f(b.w & 0xffffu); s += __uint_as_float(a.w & 0xffff0000u) * __uint_as_float(b.w & 0xffff0000u);
    return s;
}


__device__ __forceinline__ int tid_now() { int t = threadIdx.x; asm volatile("" : "+v"(t)); return t; }
__device__ __forceinline__ int lane_now() { return tid_now() & 63; }

namespace pg8 {
#define PG8_LAS __attribute__((address_space(3)))
typedef short bf16x8 __attribute__((ext_vector_type(8)));
typedef unsigned u32x4 __attribute__((ext_vector_type(4)));
typedef float f32x2 __attribute__((ext_vector_type(2)));
constexpr int BM = 256, BK = 64, HALF = 128, HTB = HALF * BK * 2, STAGE_BYTES = 8 * HTB, NXCD = 8, WGM = 8;
__host__ __device__ __forceinline__ int lds_byte(int r, int c) { const int st = (r >> 4) * 2 + (c >> 5), rr = r & 15, cc = c & 31, ob = rr * 64 + cc * 2; return st * 1024 + (ob ^ (((ob >> 9) & 1) << 5)); }
__host__ __device__ __forceinline__ void stage_rc(int b, int& R, int& C) { const int st = b / 1024, sb = b % 1024, swz = sb ^ (((sb >> 9) & 1) << 5); R = (st >> 1) * 16 + swz / 64; C = (st & 1) * 32 + (swz % 64) / 2; }
__host__ __device__ __forceinline__ int perm32(int rho) { const int n = rho >> 4, i = rho & 15; return 8 * (i >> 2) + 4 * n + (i & 3); }
struct Unit { int pm, pn; };
struct Gemm { const bf16_t* A; const bf16_t* Bt; int M, N, K, lda; };
struct StaticOrder {
    int nM, nN, nwg, G, c;
    __host__ __device__ void init(int M_, int N_, int G_, int c_) { nM = M_ / BM; nN = N_ / BM; nwg = nM * nN; G = G_; c = c_; }
    __host__ __device__ bool next(int i, Unit& u) const {
        const long L = (long)i * G + c; if (L >= nwg) return false;
        int wgid = (int)L; { const int q = nwg / NXCD, r = nwg % NXCD, xcd = wgid % NXCD, off = wgid / NXCD; wgid = (xcd < r ? xcd * (q + 1) : r * (q + 1) + (xcd - r) * q) + off; }
        const int nig = WGM * nN, gid = wgid / nig, fm = gid * WGM, gsz = (nM - fm) < WGM ? (nM - fm) : WGM;
        u.pm = fm + ((wgid % nig) % gsz); u.pn = (wgid % nig) / gsz; return true;
    }
};
__device__ __forceinline__ unsigned cvt_pk_bf16(float lo, float hi) { unsigned r; asm volatile("v_cvt_pk_bf16_f32 %0, %1, %2" : "=v"(r) : "v"(lo), "v"(hi)); return r; }
struct EpiBf16 {
    static constexpr bool PERM = true, AFTER_DRAIN = false;
    __device__ __forceinline__ void khook(f32x4 (&)[2][2][4][2], const Unit&, int, int, int) const {}
    bf16_t* O; int ldc;
    __device__ __forceinline__ void operator()(const f32x4 (&acc)[2][2][4][2], const Unit& u, int wr, int wc, int fr, int fq) const {
        const int row0 = u.pm * BM + wr * 64 + fr, col0 = u.pn * BM + wc * 32 + 8 * fq;
#pragma unroll
        for (int ai = 0; ai < 2; ++ai)
#pragma unroll
            for (int m = 0; m < 4; ++m) { bf16_t* rowp = O + (size_t)(row0 + ai * HALF + m * 16) * ldc + col0;
#pragma unroll
                for (int bj = 0; bj < 2; ++bj) { const f32x4 v0 = acc[ai][bj][m][0], v1 = acc[ai][bj][m][1];
                    u32x4 w; w.x = cvt_pk_bf16(v0[0], v0[1]); w.y = cvt_pk_bf16(v0[2], v0[3]); w.z = cvt_pk_bf16(v1[0], v1[1]); w.w = cvt_pk_bf16(v1[2], v1[3]);
                    *(u32x4*)(rowp + bj * HALF) = w; } }
    }
};
__device__ __forceinline__ float silu_fast(float g) { return g * __builtin_amdgcn_rcpf(1.f + __builtin_amdgcn_exp2f(-1.4426950408889634f * g)); }
struct EpiSwiglu {
    static constexpr bool PERM = true, AFTER_DRAIN = false;
    __device__ __forceinline__ void khook(f32x4 (&)[2][2][4][2], const Unit&, int, int, int) const {}
    bf16_t* O; int ldc;
    __device__ __forceinline__ void operator()(const f32x4 (&acc)[2][2][4][2], const Unit& u, int wr, int wc, int fr, int fq) const {
        const int row0 = u.pm * BM + wr * 64 + fr, col0 = u.pn * HALF + wc * 32 + 8 * fq;
#pragma unroll
        for (int ai = 0; ai < 2; ++ai)
#pragma unroll
            for (int m = 0; m < 4; ++m) { bf16_t* rowp = O + (size_t)(row0 + ai * HALF + m * 16) * ldc + col0;
                const f32x4 g0 = acc[ai][0][m][0], g1 = acc[ai][0][m][1], u0 = acc[ai][1][m][0], u1 = acc[ai][1][m][1];
                u32x4 w;
                w.x = cvt_pk_bf16(silu_fast(g0[0]) * u0[0], silu_fast(g0[1]) * u0[1]); w.y = cvt_pk_bf16(silu_fast(g0[2]) * u0[2], silu_fast(g0[3]) * u0[3]);
                w.z = cvt_pk_bf16(silu_fast(g1[0]) * u1[0], silu_fast(g1[1]) * u1[1]); w.w = cvt_pk_bf16(silu_fast(g1[2]) * u1[2], silu_fast(g1[3]) * u1[3]);
                *(u32x4*)rowp = w; }
    }
};
struct EpiRes {
    static constexpr bool PERM = false, AFTER_DRAIN = false;
    __device__ __forceinline__ void khook(f32x4 (&)[2][2][4][2], const Unit&, int, int, int) const {}
    const float* base; float* out; const float* gate;
    __device__ __forceinline__ void operator()(const f32x4 (&acc)[2][2][4][2], const Unit& u, int wr, int wc, int fr, int fq) const {
        const int b = (u.pm * BM) / SEQ, col0 = u.pn * BM + wc * 32 + 4 * fq;
        f32x4 gv[2][2];
#pragma unroll
        for (int bj = 0; bj < 2; ++bj)
#pragma unroll
            for (int n = 0; n < 2; ++n) gv[bj][n] = *(const f32x4*)(gate + (size_t)b * 6144 + col0 + bj * HALF + n * 16);
#pragma unroll
        for (int ai = 0; ai < 2; ++ai) {
            f32x4 bs[4][2][2];
#pragma unroll
            for (int m = 0; m < 4; ++m) { const size_t off = (size_t)(u.pm * BM + ai * HALF + wr * 64 + m * 16 + fr) * D + col0;
#pragma unroll
                for (int bj = 0; bj < 2; ++bj)
#pragma unroll
                    for (int n = 0; n < 2; ++n) bs[m][bj][n] = __builtin_nontemporal_load((const f32x4*)(base + off + bj * HALF + n * 16)); }
            asm volatile("" ::: "memory");
#pragma unroll
            for (int m = 0; m < 4; ++m) { const size_t off = (size_t)(u.pm * BM + ai * HALF + wr * 64 + m * 16 + fr) * D + col0;
#pragma unroll
                for (int bj = 0; bj < 2; ++bj)
#pragma unroll
                    for (int n = 0; n < 2; ++n) __builtin_nontemporal_store(bs[m][bj][n] + gv[bj][n] * acc[ai][bj][m][n], (f32x4*)(out + off + bj * HALF + n * 16)); }
            asm volatile("" ::: "memory");
        }
    }
};


constexpr int ST_OFF = 131072;
struct OneUnit { int pm, pn; __device__ __forceinline__ bool next(int i, Unit& u) const { if (i) return false; u.pm = pm; u.pn = pn; return true; } };
struct EpiResHook {
    static constexpr bool PERM = false, AFTER_DRAIN = false;
    const float* base; float* out; const float* gate; const float* SS; const PG8_LAS float* tab;
    __device__ __forceinline__ void sums(size_t row, float& ssb, float& smla) const {
        const f32x4 a = *(const f32x4*)(SS + row * 16), b = *(const f32x4*)(SS + row * 16 + 4), c = *(const f32x4*)(SS + row * 16 + 8);
        ssb = ((a[0] + a[1]) + (a[2] + a[3])) + ((b[0] + b[1]) + (b[2] + b[3])); smla = (c[0] + c[1]) + (c[2] + c[3]);
    }
    __device__ __forceinline__ void khook(f32x4 (&acc)[2][2][4][2], const Unit& u, int t, int wr, int fr) const {
        if (t != 8) return;
#pragma unroll
        for (int ai = 0; ai < 2; ++ai)
#pragma unroll
            for (int m = 0; m < 4; ++m) { float ratio;
                if (tab) ratio = tab[ai * HALF + wr * 64 + m * 16 + fr];
                else { float ssb, smla; sums((size_t)(u.pm * BM + ai * HALF + wr * 64 + m * 16 + fr), ssb, smla); ratio = sqrtf((smla * (1.f / 512) + EPS) / (ssb * (1.f / 512) + EPS)); }
#pragma unroll
                for (int bj = 0; bj < 2; ++bj)
#pragma unroll
                    for (int n = 0; n < 2; ++n) acc[ai][bj][m][n] *= ratio; }
    }
    __device__ __forceinline__ void operator()(const f32x4 (&acc)[2][2][4][2], const Unit& u, int wr, int wc, int fr, int fq) const {
        const int b = (u.pm * BM) / SEQ, col0 = u.pn * BM + wc * 32 + 4 * fq;
        f32x4 gv[2][2];
#pragma unroll
        for (int bj = 0; bj < 2; ++bj)
#pragma unroll
            for (int n = 0; n < 2; ++n) gv[bj][n] = *(const f32x4*)(gate + (size_t)b * 6144 + col0 + bj * HALF + n * 16);
#pragma unroll
        for (int ai = 0; ai < 2; ++ai)
#pragma unroll
            for (int m = 0; m < 4; ++m) { const size_t row = (size_t)(u.pm * BM + ai * HALF + wr * 64 + m * 16 + fr), off = row * D + col0;
                float rm;
                if (tab) rm = tab[256 + ai * HALF + wr * 64 + m * 16 + fr];
                else { float ssb, smla; sums(row, ssb, smla); rm = rsqrtf(smla * (1.f / 512) + EPS); }
#pragma unroll
                for (int bj = 0; bj < 2; ++bj)
#pragma unroll
                    for (int n = 0; n < 2; ++n) { const f32x4 bs = *(const f32x4*)(base + off + bj * HALF + n * 16);
                        *(f32x4*)(out + off + bj * HALF + n * 16) = bs + gv[bj][n] * (acc[ai][bj][m][n] * rm); } }
    }
};

struct EpiResNorm {
    static constexpr bool PERM = true, AFTER_DRAIN = true;
    const float* base; float* out; const float* modp; const PG8_LAS float* tab; const float* gffn; bf16_t* Hn; unsigned* xbuf; unsigned* cnt;
    __device__ __forceinline__ void khook(f32x4 (&acc)[2][2][4][2], const Unit&, int t, int wr, int fr) const {
        if (t != 8) return;
#pragma unroll
        for (int ai = 0; ai < 2; ++ai)
#pragma unroll
            for (int m = 0; m < 4; ++m) { const float ratio = tab[ai * HALF + wr * 64 + m * 16 + fr];
#pragma unroll
                for (int bj = 0; bj < 2; ++bj)
#pragma unroll
                    for (int n = 0; n < 2; ++n) acc[ai][bj][m][n] *= ratio; }
    }
    __device__ __forceinline__ void fused(f32x4 (&acc)[2][2][4][2], const Unit& u, int wr, int wc, int fr, int fq, PG8_LAS unsigned char* lds, int lane) const {
        PG8_LAS float* P = (PG8_LAS float*)lds;
        PG8_LAS float* S = (PG8_LAS float*)(lds + 8192);
        PG8_LAS unsigned* flag = (PG8_LAS unsigned*)(lds + 8192 + 2048);
        const int wid = wr * 4 + wc, b = (u.pm * BM) / SEQ, col0 = u.pn * BM + wc * 32 + 8 * fq;
        const float* mb = modp + (size_t)b * 6144;
        {
            f32x4 gv[2][2];
#pragma unroll
            for (int bj = 0; bj < 2; ++bj)
#pragma unroll
                for (int n = 0; n < 2; ++n) gv[bj][n] = *(const f32x4*)(mb + 2 * 1024 + col0 + bj * HALF + n * 4);
#pragma unroll
            for (int ai = 0; ai < 2; ++ai)
#pragma unroll
                for (int m = 0; m < 4; ++m) { const int r = ai * HALF + wr * 64 + m * 16 + fr; const float rm = tab[256 + r]; const float* bp = base + (size_t)(u.pm * BM + r) * D + col0;
#pragma unroll
                    for (int bj = 0; bj < 2; ++bj)
#pragma unroll
                        for (int n = 0; n < 2; ++n) acc[ai][bj][m][n] = __builtin_nontemporal_load((const f32x4*)(bp + bj * HALF + n * 4)) + gv[bj][n] * (acc[ai][bj][m][n] * rm);
                    asm volatile("" : "+v"(acc[ai][0][m][0]), "+v"(acc[ai][0][m][1]), "+v"(acc[ai][1][m][0]), "+v"(acc[ai][1][m][1]));
                    if (m == 3) asm volatile("" ::: "memory"); }
        }
#pragma unroll
        for (int ai = 0; ai < 2; ++ai)
#pragma unroll
            for (int m = 0; m < 4; ++m) { float s = 0.f;
#pragma unroll
                for (int bj = 0; bj < 2; ++bj)
#pragma unroll
                    for (int n = 0; n < 2; ++n) { const f32x4 v = acc[ai][bj][m][n]; s += (v[0] * v[0] + v[1] * v[1]) + (v[2] * v[2] + v[3] * v[3]); }
                s += __shfl_xor(s, 16); s += __shfl_xor(s, 32);
                if (fq == 0) P[(ai * HALF + wr * 64 + m * 16 + fr) * 4 + wc] = s; }
        __syncthreads();
        const int row = wid * 32 + (lane & 31);
        if (lane < 32) { const float tot = (P[row * 4] + P[row * 4 + 1]) + (P[row * 4 + 2] + P[row * 4 + 3]);
            __hip_atomic_store(xbuf + ((size_t)(u.pm * BM + row) * 4 + u.pn), __float_as_uint(tot), __ATOMIC_RELAXED, __HIP_MEMORY_SCOPE_AGENT); }
        asm volatile("s_waitcnt vmcnt(0)" ::: "memory");
        if (lane == 0) __hip_atomic_fetch_add(cnt + 64 * u.pm, 1u, __ATOMIC_RELAXED, __HIP_MEMORY_SCOPE_AGENT);
        if (wid == 0) {
            unsigned ok = 0u;
            for (unsigned sp = 0; sp < (1u << 22); ++sp) {
                if ((unsigned)__builtin_amdgcn_readfirstlane(__hip_atomic_load(cnt + 64 * u.pm, __ATOMIC_RELAXED, __HIP_MEMORY_SCOPE_AGENT)) >= 32u) { ok = 1u; break; }
                __builtin_amdgcn_s_sleep(2);
            }
            __builtin_amdgcn_fence(__ATOMIC_ACQUIRE, "agent");
            if (lane == 0) flag[0] = ok;
        }
        asm volatile("s_waitcnt vmcnt(0) lgkmcnt(0)" ::: "memory");
        __syncthreads();
        if (lane < 32) { const unsigned* sl = xbuf + (size_t)(u.pm * BM + row) * 4; float t = 0.f;
#pragma unroll
            for (int j = 0; j < 4; ++j) t += __uint_as_float(__hip_atomic_load(sl + j, __ATOMIC_RELAXED, __HIP_MEMORY_SCOPE_AGENT));
            S[row] = (flag[0] != 0u) ? rsqrtf(t * (1.f / D) + EPS) : __builtin_nanf(""); }
        __syncthreads();
        {
            f32x4 gs[2][2], sh[2][2];
#pragma unroll
            for (int bj = 0; bj < 2; ++bj)
#pragma unroll
                for (int n = 0; n < 2; ++n) { const int col = col0 + bj * HALF + n * 4;
                    gs[bj][n] = *(const f32x4*)(gffn + col) * (*(const f32x4*)(mb + 4 * 1024 + col) + 1.f); sh[bj][n] = *(const f32x4*)(mb + 3 * 1024 + col); }
#pragma unroll
            for (int ai = 0; ai < 2; ++ai)
#pragma unroll
                for (int m = 0; m < 4; ++m) { const int r = ai * HALF + wr * 64 + m * 16 + fr; const size_t off = (size_t)(u.pm * BM + r) * D + col0; const float rs = S[r];
#pragma unroll
                    for (int bj = 0; bj < 2; ++bj) { const f32x4 xa = acc[ai][bj][m][0], xb = acc[ai][bj][m][1];
                        __builtin_nontemporal_store(xa, (f32x4*)(out + off + bj * HALF)); __builtin_nontemporal_store(xb, (f32x4*)(out + off + bj * HALF + 4));
                        const f32x4 ha = xa * rs * gs[bj][0] + sh[bj][0], hb = xb * rs * gs[bj][1] + sh[bj][1];
                        u32x4 w; w.x = cvt_pk_bf16(ha[0], ha[1]); w.y = cvt_pk_bf16(ha[2], ha[3]); w.z = cvt_pk_bf16(hb[0], hb[1]); w.w = cvt_pk_bf16(hb[2], hb[3]);
                        *(u32x4*)(Hn + off + bj * HALF) = w; }
                    if (m & 1) asm volatile("" ::: "memory"); }
        }
    }
};
struct EpiQ {
    static constexpr bool PERM = true, AFTER_DRAIN = true;
    bf16_t* QM; const float* q_norm; const float* COS; const float* SIN;
    __device__ __forceinline__ void khook(f32x4 (&)[2][2][4][2], const Unit&, int, int, int) const {}
    __device__ __forceinline__ void fused(f32x4 (&acc)[2][2][4][2], const Unit& u, int wr, int wc, int fr, int fq, PG8_LAS unsigned char* lds, int lane) const {
        const PG8_LAS float* st = (const PG8_LAS float*)(lds + ST_OFF);
        PG8_LAS float* P = (PG8_LAS float*)lds;
        PG8_LAS float* X = (PG8_LAS float*)(lds + 8192);
#pragma unroll
        for (int ai = 0; ai < 2; ++ai)
#pragma unroll
            for (int m = 0; m < 4; ++m) { const int r = ai * HALF + wr * 64 + m * 16 + fr; const float rs = st[r]; float s = 0.f;
#pragma unroll
                for (int bj = 0; bj < 2; ++bj)
#pragma unroll
                    for (int n = 0; n < 2; ++n) { f32x4 v = acc[ai][bj][m][n] * rs; acc[ai][bj][m][n] = v; s += (v[0] * v[0] + v[1] * v[1]) + (v[2] * v[2] + v[3] * v[3]); }
                s += __shfl_xor(s, 16); s += __shfl_xor(s, 32);
                if (fq == 0) P[r * 4 + wc] = s; }
        __syncthreads();
        f32x4 g[2][2];
#pragma unroll
        for (int bj = 0; bj < 2; ++bj)
#pragma unroll
            for (int n = 0; n < 2; ++n) { const int j0 = bj * HALF + wc * 32 + 8 * fq + 4 * n; g[bj][n] = (j0 < MQK) ? *(const f32x4*)(q_norm + j0) : (f32x4){0.f, 0.f, 0.f, 0.f}; }
#pragma unroll
        for (int ai = 0; ai < 2; ++ai)
#pragma unroll
            for (int m = 0; m < 4; ++m) { const int r = ai * HALF + wr * 64 + m * 16 + fr;
                const float tot = (P[r * 4] + P[r * 4 + 1]) + (P[r * 4 + 2] + P[r * 4 + 3]);
                const float rq = rsqrtf(tot * (1.f / MQK) + EPS) * 0.10411754714f;
#pragma unroll
                for (int bj = 0; bj < 2; ++bj)
#pragma unroll
                    for (int n = 0; n < 2; ++n) acc[ai][bj][m][n] = acc[ai][bj][m][n] * g[bj][n] * rq; }
        if (wc < 2) {
#pragma unroll
            for (int ai = 0; ai < 2; ++ai)
#pragma unroll
                for (int m = 0; m < 4; ++m)
#pragma unroll
                    for (int n = 0; n < 2; ++n)
#pragma unroll
                        for (int i = 0; i < 4; ++i) X[((wr * 2 + wc) * 64 + (ai * 4 + m) * 8 + n * 4 + i) * 64 + lane] = acc[ai][1][m][n][i];
        }
        __syncthreads();
        if (wc < 2) {
#pragma unroll
            for (int ai = 0; ai < 2; ++ai)
#pragma unroll
                for (int m = 0; m < 4; ++m) { const size_t row = (size_t)(u.pm * BM + ai * HALF + wr * 64 + m * 16 + fr);
#pragma unroll
                    for (int n = 0; n < 2; ++n) { const f32x4 cs = *(const f32x4*)(COS + row * 32 + 8 * fq + 4 * n), sn = *(const f32x4*)(SIN + row * 32 + 8 * fq + 4 * n);
                        f32x4 v = acc[ai][1][m][n];
#pragma unroll
                        for (int i = 0; i < 4; ++i) { const float part = X[((wr * 2 + (1 - wc)) * 64 + (ai * 4 + m) * 8 + n * 4 + i) * 64 + lane];
                            v[i] = (wc == 0) ? (v[i] * cs[i] - part * sn[i]) : (v[i] * cs[i] + part * sn[i]); }
                        acc[ai][1][m][n] = v; } }
        }
#pragma unroll
        for (int ai = 0; ai < 2; ++ai)
#pragma unroll
            for (int m = 0; m < 4; ++m) { const size_t row = (size_t)(u.pm * BM + ai * HALF + wr * 64 + m * 16 + fr);
                bf16_t* rowp = QM + (row * 4 + u.pn) * MQK + wc * 32 + 8 * fq;
#pragma unroll
                for (int bj = 0; bj < 2; ++bj) { if (bj == 1 && wc >= 2) continue;
                    const f32x4 v0 = acc[ai][bj][m][0], v1 = acc[ai][bj][m][1];
                    u32x4 w; w.x = cvt_pk_bf16(v0[0], v0[1]); w.y = cvt_pk_bf16(v0[2], v0[3]); w.z = cvt_pk_bf16(v1[0], v1[1]); w.w = cvt_pk_bf16(v1[2], v1[3]);
                    *(u32x4*)(rowp + bj * HALF) = w; } }
        __syncthreads();
    }
};
struct EpiKV {
    static constexpr bool PERM = true, AFTER_DRAIN = true;
    bf16_t* KM; bf16_t* VM; const float* k_nope_norm;
    __device__ __forceinline__ void khook(f32x4 (&)[2][2][4][2], const Unit&, int, int, int) const {}
    __device__ __forceinline__ void fused(f32x4 (&acc)[2][2][4][2], const Unit& u, int wr, int wc, int fr, int fq, PG8_LAS unsigned char* lds, int lane) const {
        const PG8_LAS float* st = (const PG8_LAS float*)(lds + ST_OFF) + 256;
        PG8_LAS float* P = (PG8_LAS float*)lds;
#pragma unroll
        for (int ai = 0; ai < 2; ++ai)
#pragma unroll
            for (int m = 0; m < 4; ++m) { const int r = ai * HALF + wr * 64 + m * 16 + fr; const float rs = st[r]; float s = 0.f;
#pragma unroll
                for (int bj = 0; bj < 2; ++bj)
#pragma unroll
                    for (int n = 0; n < 2; ++n) { f32x4 v = acc[ai][bj][m][n] * rs; acc[ai][bj][m][n] = v; if (bj == 0) s += (v[0] * v[0] + v[1] * v[1]) + (v[2] * v[2] + v[3] * v[3]); }
                s += __shfl_xor(s, 16); s += __shfl_xor(s, 32);
                if (fq == 0) P[r * 4 + wc] = s; }
        __syncthreads();
        f32x4 g[2];
#pragma unroll
        for (int n = 0; n < 2; ++n) g[n] = *(const f32x4*)(k_nope_norm + wc * 32 + 8 * fq + 4 * n);
#pragma unroll
        for (int ai = 0; ai < 2; ++ai)
#pragma unroll
            for (int m = 0; m < 4; ++m) { const int r = ai * HALF + wr * 64 + m * 16 + fr; const size_t row = (size_t)(u.pm * BM + r);
                const float tot = (P[r * 4] + P[r * 4 + 1]) + (P[r * 4 + 2] + P[r * 4 + 3]);
                const float rk = rsqrtf(tot * (1.f / MNOPE) + EPS);
                const f32x4 k0 = acc[ai][0][m][0] * g[0] * rk, k1 = acc[ai][0][m][1] * g[1] * rk, v0 = acc[ai][1][m][0], v1 = acc[ai][1][m][1];
                u32x4 w; w.x = cvt_pk_bf16(k0[0], k0[1]); w.y = cvt_pk_bf16(k0[2], k0[3]); w.z = cvt_pk_bf16(k1[0], k1[1]); w.w = cvt_pk_bf16(k1[2], k1[3]);
                *(u32x4*)(KM + (row * 4 + u.pn) * MQK + wc * 32 + 8 * fq) = w;
                w.x = cvt_pk_bf16(v0[0], v0[1]); w.y = cvt_pk_bf16(v0[2], v0[3]); w.z = cvt_pk_bf16(v1[0], v1[1]); w.w = cvt_pk_bf16(v1[2], v1[3]);
                *(u32x4*)(VM + (row * 4 + u.pn) * MV + wc * 32 + 8 * fq) = w; }
        __syncthreads();
    }
};

template <class Epi, class Sched, bool ALIGN_EPI>
__device__ __forceinline__ void gemm_phase(PG8_LAS unsigned char* lds, const Gemm g, const Sched& S, const Epi& E) {
    int tid_ = threadIdx.x; asm volatile("" : "+v"(tid_));
    const int tid = tid_, wid = __builtin_amdgcn_readfirstlane(tid >> 6), lane = tid & 63, wr = wid >> 2, wc = wid & 3, fr = lane & 15, fq = lane >> 4;
    const int K = g.K, nt = K / BK, lda = g.lda;
    unsigned voffA[2], voffB[2];
#pragma unroll
    for (int i = 0; i < 2; ++i) { int R, C; stage_rc(tid * 16 + i * 8192, R, C); const int Rb = Epi::PERM ? ((R & ~31) + perm32(R & 31)) : R;
        voffA[i] = (unsigned)(R * lda + C) * 2u; voffB[i] = (unsigned)(Rb * K + C) * 2u; }
    const size_t kstep = (size_t)(BK * 2);
    const size_t hstepA = (size_t)HALF * lda * 2, hstepB = (size_t)HALF * K * 2;
    const size_t tstepA = 2 * hstepA, tstepB = 2 * hstepB;
    const unsigned ldsw = (unsigned)wid * 1024u;
    const int aoff = lds_byte(wr * 64 + fr, fq * 8), boff = lds_byte(wc * 32 + fr, fq * 8);
#define PG8_SA(b, h) (((b) * 2 + (h)) * HTB)
#define PG8_SB(b, h) ((4 + (b) * 2 + (h)) * HTB)
#define PG8_STAGE(bufoff, gbase, voff) do { _Pragma("unroll") for (int _i = 0; _i < 2; ++_i) \
        __builtin_amdgcn_global_load_lds((const unsigned*)((const char*)(gbase) + (voff)[_i]), (PG8_LAS unsigned*)(lds + (bufoff) + ldsw + _i * 8192), 16, 0, 0); } while (0)
#define PG8_LDA(dst, b, h) do { _Pragma("unroll") for (int m = 0; m < 4; ++m) _Pragma("unroll") for (int k = 0; k < 2; ++k) dst[m][k] = *(const PG8_LAS bf16x8*)(lds + PG8_SA(b, h) + aoff + m * 2048 + k * 1024); } while (0)
#define PG8_LDB(dst, b, h) do { _Pragma("unroll") for (int n = 0; n < 2; ++n) _Pragma("unroll") for (int k = 0; k < 2; ++k) dst[n][k] = *(const PG8_LAS bf16x8*)(lds + PG8_SB(b, h) + boff + n * 2048 + k * 1024); } while (0)
#define PG8_MMA(ai, bj, At, Bt) do { __builtin_amdgcn_s_setprio(1); _Pragma("unroll") for (int m = 0; m < 4; ++m) _Pragma("unroll") for (int n = 0; n < 2; ++n) _Pragma("unroll") for (int k = 0; k < 2; ++k) \
        acc[ai][bj][m][n] = __builtin_amdgcn_mfma_f32_16x16x32_bf16(Bt[n][k], At[m][k], acc[ai][bj][m][n], 0, 0, 0); __builtin_amdgcn_s_setprio(0); } while (0)
#define PG8_WAIT_V(n) asm volatile("s_waitcnt vmcnt(" #n ")" ::: "memory")
#define PG8_WAIT_L(n) asm volatile("s_waitcnt lgkmcnt(" #n ")" ::: "memory")
#define PG8_BAR __builtin_amdgcn_s_barrier()
#define PG8_SCHED __builtin_amdgcn_sched_barrier(0)
    Unit cur, nxt; int ui = 0;
    if (!S.next(0, cur)) return;
    f32x4 acc[2][2][4][2];
#pragma unroll
    for (int a = 0; a < 2; ++a)
#pragma unroll
        for (int b = 0; b < 2; ++b)
#pragma unroll
            for (int m = 0; m < 4; ++m)
#pragma unroll
                for (int n = 0; n < 2; ++n) acc[a][b][m][n] = (f32x4){0.f, 0.f, 0.f, 0.f};
    bf16x8 At[4][2], B0[2][2], B1[2][2];
    const char* cA = (const char*)g.A + (size_t)cur.pm * tstepA; const char* cB = (const char*)g.Bt + (size_t)cur.pn * tstepB;
    PG8_STAGE(PG8_SB(0, 0), cB, voffB); PG8_STAGE(PG8_SB(0, 1), cB + hstepB, voffB); PG8_STAGE(PG8_SA(0, 0), cA, voffA); PG8_STAGE(PG8_SA(0, 1), cA + hstepA, voffA);
    if (wr == 1) PG8_BAR;
    PG8_WAIT_V(2); PG8_BAR;
    PG8_STAGE(PG8_SB(1, 0), cB + kstep, voffB); PG8_STAGE(PG8_SA(1, 0), cA + kstep, voffA); PG8_STAGE(PG8_SB(1, 1), cB + hstepB + kstep, voffB);
    PG8_WAIT_V(6); PG8_BAR;
    for (;;) {
        const bool has_next = S.next(ui + 1, nxt);
        const char* nA = has_next ? (const char*)g.A + (size_t)nxt.pm * tstepA : cA; const char* nB = has_next ? (const char*)g.Bt + (size_t)nxt.pn * tstepB : cB;
#pragma nounroll
        for (int t = 0; t < nt; t += 2) {
            const bool last = (t == nt - 2);
            const char* a1 = cA + (size_t)(t + 1) * kstep;
            const char* a2 = last ? nA : cA + (size_t)(t + 2) * kstep; const char* b2 = last ? nB : cB + (size_t)(t + 2) * kstep;
            const char* a3 = a2 + kstep; const char* b3 = b2 + kstep;
            E.khook(acc, cur, t, wr, fr);
            PG8_LDB(B0, 0, 0); PG8_LDB(B1, 0, 1); PG8_SCHED; PG8_LDA(At, 0, 0); PG8_STAGE(PG8_SA(1, 1), a1 + hstepA, voffA);
            PG8_WAIT_V(8); PG8_WAIT_L(0); PG8_BAR; PG8_MMA(0, 0, At, B0); PG8_MMA(0, 1, At, B1); PG8_BAR; PG8_SCHED;
            PG8_LDA(At, 0, 1); PG8_STAGE(PG8_SB(0, 0), b2, voffB); PG8_STAGE(PG8_SB(0, 1), b2 + hstepB, voffB); PG8_STAGE(PG8_SA(0, 0), a2, voffA);
            PG8_WAIT_V(8); PG8_WAIT_L(0); PG8_BAR; PG8_MMA(1, 0, At, B0); PG8_MMA(1, 1, At, B1); PG8_BAR; PG8_SCHED;
            PG8_LDB(B0, 1, 0); PG8_LDB(B1, 1, 1); PG8_SCHED; PG8_LDA(At, 1, 0); PG8_STAGE(PG8_SA(0, 1), a2 + hstepA, voffA);
            PG8_WAIT_V(8); PG8_WAIT_L(0); PG8_BAR; PG8_MMA(0, 0, At, B0); PG8_MMA(0, 1, At, B1); PG8_BAR; PG8_SCHED;
            PG8_LDA(At, 1, 1); PG8_STAGE(PG8_SB(1, 0), b3, voffB); PG8_STAGE(PG8_SB(1, 1), b3 + hstepB, voffB); PG8_STAGE(PG8_SA(1, 0), a3, voffA);
            PG8_WAIT_V(8); PG8_WAIT_L(0); PG8_BAR; PG8_MMA(1, 0, At, B0); PG8_MMA(1, 1, At, B1); PG8_BAR; PG8_SCHED;
        }
        if constexpr (ALIGN_EPI) { if (wr == 0) PG8_BAR; }
        if constexpr (!Epi::AFTER_DRAIN) E(acc, cur, wr, wc, fr, fq);
        if (!has_next) break;
#pragma unroll
        for (int a = 0; a < 2; ++a)
#pragma unroll
            for (int b = 0; b < 2; ++b)
#pragma unroll
                for (int m = 0; m < 4; ++m)
#pragma unroll
                    for (int n = 0; n < 2; ++n) acc[a][b][m][n] = (f32x4){0.f, 0.f, 0.f, 0.f};
        cur = nxt; cA = nA; cB = nB; ++ui;
        if constexpr (ALIGN_EPI) { if (wr == 1) PG8_BAR; }
    }
    PG8_WAIT_V(0);
    if constexpr (!ALIGN_EPI) { if (wr == 0) PG8_BAR; }
    PG8_BAR;
    if constexpr (Epi::AFTER_DRAIN) E.fused(acc, cur, wr, wc, fr, fq, lds, lane);
#undef PG8_SA
#undef PG8_SB
#undef PG8_STAGE
#undef PG8_LDA
#undef PG8_LDB
#undef PG8_MMA
#undef PG8_WAIT_V
#undef PG8_WAIT_L
#undef PG8_BAR
#undef PG8_SCHED
}
}


namespace att {
typedef short bf16x8 __attribute__((ext_vector_type(8)));
typedef short s16x4 __attribute__((ext_vector_type(4)));
typedef _Float16 f16x8 __attribute__((ext_vector_type(8)));
typedef _Float16 f16x2 __attribute__((ext_vector_type(2)));
typedef float f32x16 __attribute__((ext_vector_type(16)));
typedef float f32x2v __attribute__((ext_vector_type(2)));
typedef __bf16 bf16x2_t __attribute__((ext_vector_type(2)));
constexpr int BUFB = 46080, KV_OFF = 25600;
constexpr int WS_OFF = 136192, SLOT_OFF = WS_OFF + 2048, FLAG_OFF = SLOT_OFF + 64;
__device__ __forceinline__ int crow(int r, int hi) { return (r & 3) + 8 * (r >> 2) + 4 * hi; }
__device__ __forceinline__ constexpr int crowc(int r) { return (r & 3) + 8 * (r >> 2); }
__device__ __forceinline__ unsigned cvtpk_bf16(float lo, float hi) { f32x2v v = {lo, hi}; bf16x2_t b = __builtin_convertvector(v, bf16x2_t); return __builtin_bit_cast(unsigned, b); }
__device__ __forceinline__ unsigned cvtpk_f16(float lo, float hi) { f32x2v v = {lo, hi}; f16x2 b = __builtin_convertvector(v, f16x2); return __builtin_bit_cast(unsigned, b); }
#define ATT_EX2(x) __builtin_amdgcn_exp2f(x)
#define ATT_LG2(x) __builtin_amdgcn_logf(x)

template <int DQK, int DV> struct TileRegs { v4u k[DQK / 64]; v4u v[DV / 64]; };
template <int DQK, int DV>
__device__ __forceinline__ void tile_load(TileRegs<DQK, DV>& R, const bf16_t* Kg, int ks, const bf16_t* Vg, int vs, int k0, int) {
    const int tid = tid_now();
#pragma unroll
    for (int i = 0; i < DQK / 64; ++i) { const int ch = tid + 512 * i, row = ch / (DQK / 8), c = ch % (DQK / 8); R.k[i] = *(const v4u*)(Kg + (size_t)(k0 + row) * ks + c * 8); }
#pragma unroll
    for (int i = 0; i < DV / 64; ++i) { const int ch = tid + 512 * i, row = ch / (DV / 8), c = ch % (DV / 8); R.v[i] = *(const v4u*)(Vg + (size_t)(k0 + row) * vs + c * 8); }
}
template <int DQK, int DV>
__device__ __forceinline__ void tile_store(const TileRegs<DQK, DV>& R, LAS unsigned char* buf, int, const int voff = KV_OFF) {
    const int tid = tid_now();
    constexpr int KROWB = (DQK + 8) * 2, VROWB = (DV + 32) * 2;
#pragma unroll
    for (int i = 0; i < DQK / 64; ++i) { const int ch = tid + 512 * i, row = ch / (DQK / 8), c = ch % (DQK / 8); *(LAS v4u*)(buf + row * KROWB + c * 16) = R.k[i]; }
#pragma unroll
    for (int i = 0; i < DV / 64; ++i) { const int ch = tid + 512 * i, row = ch / (DV / 8), c = ch % (DV / 8); *(LAS v4u*)(buf + voff + row * VROWB + c * 16) = R.v[i]; }
}
typedef short v4i16_t __attribute__((ext_vector_type(4)));
__device__ __forceinline__ s16x4 vtr(const LAS unsigned char* p) { return __builtin_bit_cast(s16x4, __builtin_amdgcn_ds_read_tr16_b64_v4i16((LAS v4i16_t*)p)); }
template <int VROWB>
__device__ __forceinline__ bf16x8 vfrag(const LAS unsigned char* vb, int db, int p, int s2) {
    const s16x4 lo = vtr(vb + (32 * p + 16 * s2) * VROWB + 64 * db);
    const s16x4 hi = vtr(vb + (32 * p + 16 * s2 + 8) * VROWB + 64 * db);
    return (bf16x8){lo[0], lo[1], lo[2], lo[3], hi[0], hi[1], hi[2], hi[3]};
}
#define ATT_PACK8(X, B) __builtin_bit_cast(bf16x8, (v4u){cvtpk_bf16(X[B], X[B + 1]), cvtpk_bf16(X[B + 2], X[B + 3]), cvtpk_bf16(X[B + 4], X[B + 5]), cvtpk_bf16(X[B + 6], X[B + 7])})
#define ATT_PACKH8(X, B) __builtin_bit_cast(f16x8, (v4u){cvtpk_f16(X[B], X[B + 1]), cvtpk_f16(X[B + 2], X[B + 3]), cvtpk_f16(X[B + 4], X[B + 5]), cvtpk_f16(X[B + 6], X[B + 7])})

__device__ __forceinline__ void sb_tile(const bool DIAG, const LAS unsigned char* lds, const int voff, const bf16x8 (&qf)[4], const f16x8 (&Ud)[2], f16x8 ones, f32x16& o0, f32x16& o1, float& carry, int k0, int qw0, int r32, int hi) {
    constexpr int KROWB = 144;
    f32x16 p0 = {}, p1 = {};
    const LAS unsigned char* kb = lds + r32 * KROWB + hi * 16;
#pragma unroll
    for (int s = 0; s < 4; ++s) {
        const bf16x8 a0 = *(const LAS bf16x8*)(kb + s * 32), a1 = *(const LAS bf16x8*)(kb + 32 * KROWB + s * 32);
        p0 = __builtin_amdgcn_mfma_f32_32x32x16_bf16(a0, qf[s], p0, 0, 0, 0);
        p1 = __builtin_amdgcn_mfma_f32_32x32x16_bf16(a1, qf[s], p1, 0, 0, 0);
    }
    const int qrel = qw0 + r32 - k0 - 4 * hi;
    f32x16 c0, c1, lm0, lm1;
    float lb00;
#pragma unroll
    for (int r = 0; r < 16; ++r) {
        { const float z = p0[r], e = ATT_EX2(-__builtin_fabsf(z)), lp = ATT_LG2(1.0f + e); const float mn = __builtin_amdgcn_fmed3f(z, -INFINITY, 0.0f);
          const float lb = mn - lp; lm0[r] = lb - z; c0[r] = lb + carry; if (r == 0) lb00 = lb; }
        { const float z = p1[r], e = ATT_EX2(-__builtin_fabsf(z)), lp = ATT_LG2(1.0f + e); const float mn = __builtin_amdgcn_fmed3f(z, -INFINITY, 0.0f);
          const float lb = mn - lp; lm1[r] = lb - z; c1[r] = lb + carry; }
    }
    if (DIAG) {
#pragma unroll
        for (int r = 0; r < 16; ++r) { lm0[r] = (crowc(r) < qrel) ? lm0[r] : 0.f; lm1[r] = (32 + crowc(r) < qrel) ? lm1[r] : 0.f; }
    }
    const f16x8 L00 = ATT_PACKH8(lm0, 0), L01 = ATT_PACKH8(lm0, 8), L10 = ATT_PACKH8(lm1, 0), L11 = ATT_PACKH8(lm1, 8);
    c0 = __builtin_amdgcn_mfma_f32_32x32x16_f16(Ud[0], L00, c0, 0, 0, 0);
    c1 = __builtin_amdgcn_mfma_f32_32x32x16_f16(Ud[0], L10, c1, 0, 0, 0);
    c0 = __builtin_amdgcn_mfma_f32_32x32x16_f16(Ud[1], L01, c0, 0, 0, 0);
    c1 = __builtin_amdgcn_mfma_f32_32x32x16_f16(Ud[1], L11, c1, 0, 0, 0);
    c0 = __builtin_amdgcn_mfma_f32_32x32x16_f16(ones, L10, c0, 0, 0, 0);
    c0 = __builtin_amdgcn_mfma_f32_32x32x16_f16(ones, L11, c0, 0, 0, 0);
    carry = __shfl((c0[0] - lb00) + lm0[0], r32);
    f32x16 w0, w1;
#pragma unroll
    for (int r = 0; r < 16; ++r) { w0[r] = ATT_EX2(c0[r]); w1[r] = ATT_EX2(c1[r]); }
    if (DIAG) {
#pragma unroll
        for (int r = 0; r < 16; ++r) { w0[r] = (crowc(r) < qrel) ? w0[r] : 0.f; w1[r] = (32 + crowc(r) < qrel) ? w1[r] : 0.f; }
    }
    const bf16x8 W00 = ATT_PACK8(w0, 0), W01 = ATT_PACK8(w0, 8), W10 = ATT_PACK8(w1, 0), W11 = ATT_PACK8(w1, 8);
    const int lane_ = r32 + 32 * hi;
    const LAS unsigned char* vb = lds + voff + (4 * hi + ((lane_ & 15) >> 2)) * 192 + 32 * ((lane_ >> 4) & 1) + 8 * (lane_ & 3);
#define vfrag vfrag<192>
    o0 = __builtin_amdgcn_mfma_f32_32x32x16_bf16(W00, vfrag(vb, 0, 0, 0), o0, 0, 0, 0);
    o1 = __builtin_amdgcn_mfma_f32_32x32x16_bf16(W00, vfrag(vb, 1, 0, 0), o1, 0, 0, 0);
    o0 = __builtin_amdgcn_mfma_f32_32x32x16_bf16(W01, vfrag(vb, 0, 0, 1), o0, 0, 0, 0);
    o1 = __builtin_amdgcn_mfma_f32_32x32x16_bf16(W01, vfrag(vb, 1, 0, 1), o1, 0, 0, 0);
    o0 = __builtin_amdgcn_mfma_f32_32x32x16_bf16(W10, vfrag(vb, 0, 1, 0), o0, 0, 0, 0);
    o1 = __builtin_amdgcn_mfma_f32_32x32x16_bf16(W10, vfrag(vb, 1, 1, 0), o1, 0, 0, 0);
    o0 = __builtin_amdgcn_mfma_f32_32x32x16_bf16(W11, vfrag(vb, 0, 1, 1), o0, 0, 0, 0);
    o1 = __builtin_amdgcn_mfma_f32_32x32x16_bf16(W11, vfrag(vb, 1, 1, 1), o1, 0, 0, 0);
#undef vfrag
}
__device__ __forceinline__ void sb_unit(LAS unsigned char* lds, const bf16_t* PROJ, bf16_t* O, float* SS, int b, int h, int qb) {
    const int tid = threadIdx.x, lane = tid & 63, r32 = lane & 31, hi = lane >> 5, wid = __builtin_amdgcn_readfirstlane(tid >> 6);
    const int q0 = qb * 256, qw0 = q0 + 32 * wid;
    const bf16_t* Qg = PROJ + (size_t)(b * SEQ) * NPROJ + h * 64; const bf16_t* Kg = Qg + 512; const bf16_t* Vg = Qg + 1024;
    bf16x8 qf[4];
#pragma unroll
    for (int s = 0; s < 4; ++s) qf[s] = *(const bf16x8*)(Qg + (size_t)(qw0 + r32) * NPROJ + 16 * s + 8 * hi);
    f16x8 Ud[2], ones;
#pragma unroll
    for (int s2 = 0; s2 < 2; ++s2)
#pragma unroll
        for (int e = 0; e < 8; ++e) Ud[s2][e] = ((16 * s2 + 8 * (e >> 2) + 4 * hi + (e & 3)) > r32) ? (_Float16)1.0f : (_Float16)0.0f;
#pragma unroll
    for (int e = 0; e < 8; ++e) ones[e] = (_Float16)1.0f;
    f32x16 o0 = {}, o1 = {}; float carry = 0.f;
    constexpr int SBB = 21504, SBV = 9216, NS = 6;
    const int T0 = 4 * qb, Tw = T0 + (wid >> 1), nstep = T0 + 4;
    {
        TileRegs<64, 64> P[4];
#pragma unroll
        for (int jj = 0; jj < 4; ++jj) tile_load<64, 64>(P[jj], Kg, NPROJ, Vg, NPROJ, (T0 + jj) * 64, tid);
#pragma unroll
        for (int jj = 0; jj < 4; ++jj) tile_store<64, 64>(P[jj], lds + ((T0 + jj) % NS) * SBB, tid, SBV);
    }
    TileRegs<64, 64> R;
    if (T0 >= 1) tile_load<64, 64>(R, Kg, NPROJ, Vg, NPROJ, (T0 - 1) * 64, tid);
    LAS unsigned* flags = (LAS unsigned*)(lds + FLAG_OFF);
    bool dead = false;
    if (lane == 0) flags[8 + wid] = 0u;
    for (int i = 0; i < nstep; ++i) {
        __syncthreads();
        { const LAS unsigned* fl = flags + ((i + 1) & 1) * 8;
          const unsigned all = fl[0] & fl[1] & fl[2] & fl[3] & fl[4] & fl[5] & fl[6] & fl[7];
          if (all) break; }
        const int tn = T0 - i - 1;
        if (tn >= 0) { tile_store<64, 64>(R, lds + (tn % NS) * SBB, tid, SBV); if (tn >= 1) tile_load<64, 64>(R, Kg, NPROJ, Vg, NPROJ, (tn - 1) * 64, tid); }
        const int T = Tw - i;
        if (T >= 0 && !dead) {
            sb_tile(i == 0, lds + (T % NS) * SBB, SBV, qf, Ud, ones, o0, o1, carry, T * 64, qw0, r32, hi);
            dead = !__any(carry >= -160.f);
        }
        if (lane == 0) flags[(i & 1) * 8 + wid] = (dead || T < 1) ? 1u : 0u;
    }
#pragma unroll
    for (int r = 0; r < 16; ++r) {
        const size_t row = (size_t)b * SEQ + qw0 + crow(r, hi);
        O[row * D + h * 64 + r32] = (bf16_t)f2bf(o0[r]); O[row * D + h * 64 + 32 + r32] = (bf16_t)f2bf(o1[r]);
        float ss = o0[r] * o0[r] + o1[r] * o1[r];
        ss += __shfl_xor(ss, 1); ss += __shfl_xor(ss, 2); ss += __shfl_xor(ss, 4); ss += __shfl_xor(ss, 8); ss += __shfl_xor(ss, 16);
        if (r32 == 0) SS[row * 16 + h] = ss;
    }
}

__device__ __forceinline__ void mla_half(const bool DIAG, const int p, const LAS unsigned char* lds, LAS float* wsf, const bf16x8 (&qf)[12], f32x16 (&o)[4], float& m_run, float& l_run, int k0, int qw0, int r32, int hi) {
    constexpr int KROWB = 400;
    f32x16 p0 = {};
    const LAS unsigned char* kb = lds + (32 * p + r32) * KROWB + hi * 16;
    bf16x8 ka[4];
    ka[0] = *(const LAS bf16x8*)(kb); ka[1] = *(const LAS bf16x8*)(kb + 32); ka[2] = *(const LAS bf16x8*)(kb + 64);
#pragma unroll
    for (int s = 0; s < 12; ++s) {
        if (s + 3 < 12) ka[(s + 3) & 3] = *(const LAS bf16x8*)(kb + (s + 3) * 32);
        __builtin_amdgcn_sched_barrier(0);
        p0 = __builtin_amdgcn_mfma_f32_32x32x16_bf16(ka[s & 3], qf[s], p0, 0, 0, 0);
        __builtin_amdgcn_sched_barrier(0);
    }
    if (DIAG) {
        const int qrel = qw0 + r32 - k0 - 32 * p - 4 * hi;
#pragma unroll
        for (int r = 0; r < 16; ++r) { if (crowc(r) > qrel) p0[r] = -INFINITY; }
    }
    float mt = p0[0];
#pragma unroll
    for (int r = 1; r < 16; ++r) mt = __builtin_fmaxf(mt, p0[r]);
    mt = __builtin_fmaxf(mt, __shfl_xor(mt, 32));
    if (__any(mt > m_run + 8.0f)) {
        const float mn = __builtin_fmaxf(m_run, mt), corr = ATT_EX2(m_run - mn);
        m_run = mn;
        l_run *= corr;
        if (hi == 0) wsf[r32] = corr;
        const LAS float* wsfh = wsf + 4 * hi;
#pragma unroll
        for (int r = 0; r < 16; ++r) { const float f = wsfh[crowc(r)];
#pragma unroll
            for (int db = 0; db < 4; ++db) o[db][r] *= f; }
    }
    float rs = 0.f;
#pragma unroll
    for (int r = 0; r < 16; ++r) { p0[r] = ATT_EX2(p0[r] - m_run); rs += p0[r]; }
    l_run += rs;
    const bf16x8 W0 = ATT_PACK8(p0, 0), W1 = ATT_PACK8(p0, 8);
    const int lane_ = r32 + 32 * hi;
    const LAS unsigned char* vb = lds + KV_OFF + (4 * hi + ((lane_ & 15) >> 2)) * 320 + 32 * ((lane_ >> 4) & 1) + 8 * (lane_ & 3);
    bf16x8 vf[3];
    vf[0] = vfrag<320>(vb, 0, p, 0); vf[1] = vfrag<320>(vb, 0, p, 1);
#pragma unroll
    for (int i = 0; i < 8; ++i) {
        if (i + 2 < 8) vf[(i + 2) % 3] = vfrag<320>(vb, (i + 2) >> 1, p, (i + 2) & 1);
        __builtin_amdgcn_sched_barrier(0);
        o[i >> 1] = __builtin_amdgcn_mfma_f32_32x32x16_bf16((i & 1) ? W1 : W0, vf[i % 3], o[i >> 1], 0, 0, 0);
        __builtin_amdgcn_sched_barrier(0);
    }
}
__device__ __forceinline__ void mla_unit(LAS unsigned char* lds, const bf16_t* QM, const bf16_t* KM, const bf16_t* VM, bf16_t* O, float* SS, int b, int h, int qb) {
    const int tid = threadIdx.x, lane = tid & 63, r32 = lane & 31, hi = lane >> 5, wid = __builtin_amdgcn_readfirstlane(tid >> 6);
    const int q0 = qb * 256, qw0 = q0 + 32 * wid;
    const bf16_t* Qg = QM + ((size_t)(b * SEQ) * 4 + h) * MQK; const bf16_t* Kg = KM + ((size_t)(b * SEQ) * 4 + h) * MQK; const bf16_t* Vg = VM + ((size_t)(b * SEQ) * 4 + h) * MV;
    LAS float* wsf = (LAS float*)(lds + WS_OFF) + wid * 64;
    bf16x8 qf[12];
#pragma unroll
    for (int s = 0; s < 12; ++s) qf[s] = *(const bf16x8*)(Qg + (size_t)(qw0 + r32) * (4 * MQK) + 16 * s + 8 * hi);
    f32x16 o[4] = {{}, {}, {}, {}}; float m_run = -INFINITY, l_run = 0.f;
    const int ntile = (q0 + 256) / 64;
    TileRegs<192, 128> R;
    tile_load<192, 128>(R, Kg, 4 * MQK, Vg, 4 * MV, 0, tid);
    tile_store<192, 128>(R, lds, tid);
    tile_load<192, 128>(R, Kg, 4 * MQK, Vg, 4 * MV, 64, tid);
    for (int t = 0; t < ntile; ++t) {
        __syncthreads();
        if (t + 1 < ntile) { tile_store<192, 128>(R, lds + ((t + 1) & 1) * BUFB, tid); if (t + 2 < ntile) tile_load<192, 128>(R, Kg, 4 * MQK, Vg, 4 * MV, (t + 2) * 64, tid); }
        const int k0 = t * 64;
        const LAS unsigned char* buf = lds + (t & 1) * BUFB;
        if (k0 <= qw0 + 31) {
            mla_half(k0 + 31 > qw0, 0, buf, wsf, qf, o, m_run, l_run, k0, qw0, r32, hi);
            if (k0 + 32 <= qw0 + 31) mla_half(k0 + 63 > qw0, 1, buf, wsf, qf, o, m_run, l_run, k0, qw0, r32, hi);
        }
    }
    const float lt = l_run + __shfl_xor(l_run, 32);
    if (hi == 0) wsf[r32] = 1.0f / lt;
    float f[16];
#pragma unroll
    for (int r = 0; r < 16; ++r) f[r] = wsf[crow(r, hi)];
#pragma unroll
    for (int r = 0; r < 16; ++r) {
        const size_t row = (size_t)b * SEQ + qw0 + crow(r, hi);
        float ss = 0.f;
#pragma unroll
        for (int db = 0; db < 4; ++db) { const float v = o[db][r] * f[r]; O[row * D + 512 + h * 128 + 32 * db + r32] = (bf16_t)f2bf(v); ss += v * v; }
        ss += __shfl_xor(ss, 1); ss += __shfl_xor(ss, 2); ss += __shfl_xor(ss, 4); ss += __shfl_xor(ss, 8); ss += __shfl_xor(ss, 16);
        if (r32 == 0) SS[row * 16 + 8 + h] = ss;
    }
}
}

struct Args { const float* in[21]; float* out; unsigned char* ws; int ph_lo, ph_hi; };

struct Frame {
    LAS unsigned char* lds;
    int wave, G, bid;
    const float *x, *c, *w_ada, *b_ada, *norm_attn, *norm_ffn, *w_in, *q_a_norm, *w_q_up, *kv_a_norm, *w_kv_up, *q_norm, *k_nope_norm, *k_rope_norm,
        *out_norm_sb, *out_norm_mla, *w_out, *w_gate, *w_up, *w_down;
    const int* pos;
    float* out;
    float* mod;
    bf16_t *Win_t, *Wq_t, *Wkv_t, *Wout_t, *Wgu_t, *Wd_t;
    float* SS;
    bf16_t *H, *PROJ, *QM, *KM, *VM, *O, *A2;
    float *COS, *SIN;
};

__device__ __forceinline__ void transpose_item(const float* W, int K, int N, bf16_t* WT, LAS float* scr, int item, int lane, int mode, const float* g0, const float* g1) {
    const int nblk = N / 32, kb = item / nblk, nb = item % nblk, k0 = 64 * kb, n0 = 32 * nb;
    const float nsc = (mode == 0 && n0 < 512) ? 0.18033688011112042f : 1.f;
#pragma unroll 8
    for (int i = 0; i < 32; ++i) {
        const int kk = 2 * i + (lane >> 5), k = k0 + kk;
        float gk = 1.f;
        if (mode == 1 || mode == 2) gk = g0[k];
        if (mode == 3) gk = (k < 512) ? g0[k] : g1[k - 512];
        scr[kk * 33 + (lane & 31)] = __builtin_nontemporal_load(W + (size_t)k * N + n0 + (lane & 31)) * gk * nsc;
    }
    asm volatile("s_waitcnt lgkmcnt(0)" ::: "memory");
    const int c = lane & 7;
#pragma unroll
    for (int j = 0; j < 4; ++j) {
        const int nn = (lane >> 3) + 8 * j, n = n0 + nn;
        int row = n;
        if (mode == 1) row = (n / 192) * 256 + (n % 192);
        if (mode == 4) row = (n / 128) * 256 + (n % 128);
        if (mode == 5) row = (n / 128) * 256 + (n % 128) + 128;
        const LAS float* s = scr + (8 * c) * 33 + nn;
        v4u o; o.x = pk2(s[0 * 33], s[1 * 33]); o.y = pk2(s[2 * 33], s[3 * 33]); o.z = pk2(s[4 * 33], s[5 * 33]); o.w = pk2(s[6 * 33], s[7 * 33]);
        *(v4u*)(WT + (size_t)row * K + k0 + 8 * c) = o;
    }
    asm volatile("s_waitcnt lgkmcnt(0)" ::: "memory");
}

__device__ __forceinline__ void p0_prep(Frame& F) {
    LAS float* sc = (LAS float*)F.lds;
    LAS float* red = (LAS float*)(F.lds + 32768);
    if (F.bid < 192) {
        for (int i = tid_now(); i < 8 * 1024; i += NT) sc[i] = siluf(F.c[i]);
        __syncthreads();
        for (int it = F.bid; it < 192; it += F.G) {
            const int tid = tid_now(), cq = tid & 7, kg = tid >> 3, n0 = it * 32 + 4 * cq;
            f32x4 w4[16];
#pragma unroll
            for (int kk = 0; kk < 16; ++kk) w4[kk] = __builtin_nontemporal_load((const f32x4*)(F.w_ada + (size_t)(kg * 16 + kk) * 6144 + n0));
            f32x4 acc[8];
#pragma unroll
            for (int b = 0; b < 8; ++b) acc[b] = (f32x4){0.f, 0.f, 0.f, 0.f};
#pragma unroll
            for (int kk = 0; kk < 16; ++kk)
#pragma unroll
                for (int b = 0; b < 8; ++b) acc[b] += w4[kk] * sc[b * 1024 + kg * 16 + kk];
#pragma unroll
            for (int b = 0; b < 8; ++b) *(LAS f32x4*)(red + (kg * 8 + b) * 32 + 4 * cq) = acc[b];
            __syncthreads();
            if (tid < 256) {
                const int b = tid >> 5, j = tid & 31, n = it * 32 + j;
                float s = F.b_ada[n];
#pragma unroll 8
                for (int g = 0; g < 64; ++g) s += red[(g * 8 + b) * 32 + j];
                F.mod[b * 6144 + n] = s;
            }
            __syncthreads();
        }
    }
    __syncthreads();
    LAS float* scr = (LAS float*)(F.lds + F.wave * 16384);
    const int gw = F.bid * NW + F.wave, NGW = F.G * NW;
    constexpr int I_IN = (D / 64) * (NPROJ_REAL / 32), I_Q = (QRANK / 64) * (768 / 32), I_KV = (KVRANK / 64) * (1024 / 32), I_O = (D / 64) * (D / 32),
                  I_G = (D / 64) * (FF / 32), I_D = (FF / 64) * (D / 32);
    (void)I_Q; (void)I_KV; (void)I_O;
    {
        const bool split = false;
        const int first = split ? 192 : 0, nb = F.G - first;
        if (F.bid >= first) {
            const int gw2 = (F.bid - first) * NW + F.wave, NGW2 = nb * NW;
            for (int it = gw2; it < I_IN; it += NGW2) transpose_item(F.w_in, D, NPROJ_REAL, F.Win_t, scr, it, lane_now(), 0, nullptr, nullptr);
        }
    }
    {
        const int gt = F.bid * NT + tid_now(), NGT = F.G * NT;
        const v4u z = (v4u){0u, 0u, 0u, 0u};
        for (int i = gt; i < 64 * 1024 / 8; i += NGT) *(v4u*)(F.Win_t + (size_t)NPROJ_REAL * D + (size_t)i * 8) = z;
        for (int i = gt; i < 4 * 64 * 384 / 8; i += NGT) {
            const int h = i / (64 * 384 / 8), r = i % (64 * 384 / 8);
            *(v4u*)(F.Wq_t + (size_t)(h * 256 + 192) * QRANK + (size_t)r * 8) = z;
        }
    }
}


__device__ __forceinline__ void p2_tail_ffn_weights(Frame& F) {
    const int first = (F.G > 64) ? 64 : 0, nb = F.G - first;
    if (F.bid < first) return;
    LAS float* scr = (LAS float*)(F.lds + F.wave * 16384);
    const int gw = (F.bid - first) * NW + F.wave, NGW = nb * NW;
    constexpr int I_G = (D / 64) * (FF / 32), I_D = (FF / 64) * (D / 32), I_Q = (QRANK / 64) * (768 / 32), I_KV = (KVRANK / 64) * (1024 / 32), I_O = (D / 64) * (D / 32);
    for (int it = gw; it < I_Q + I_KV + I_O + 2 * I_G + I_D; it += NGW) {
        int r = it;
        if (r < I_Q) { transpose_item(F.w_q_up, QRANK, 768, F.Wq_t, scr, r, lane_now(), 1, F.q_a_norm, nullptr); continue; } r -= I_Q;
        if (r < I_KV) { transpose_item(F.w_kv_up, KVRANK, 1024, F.Wkv_t, scr, r, lane_now(), 2, F.kv_a_norm, nullptr); continue; } r -= I_KV;
        if (r < I_O) { transpose_item(F.w_out, D, D, F.Wout_t, scr, r, lane_now(), 3, F.out_norm_sb, F.out_norm_mla); continue; } r -= I_O;
        if (r < I_G) { transpose_item(F.w_gate, D, FF, F.Wgu_t, scr, r, lane_now(), 4, nullptr, nullptr); continue; } r -= I_G;
        if (r < I_G) { transpose_item(F.w_up, D, FF, F.Wgu_t, scr, r, lane_now(), 5, nullptr, nullptr); continue; } r -= I_G;
        transpose_item(F.w_down, FF, D, F.Wd_t, scr, r, lane_now(), 6, nullptr, nullptr);
    }
}

__device__ __forceinline__ void p_hnorm(Frame& F, const float* X, const float* g, int ishift, int iscale, bf16_t* Hout) {
    const int vb = (F.G % 8 == 0) ? (F.bid % 8) * (F.G / 8) + F.bid / 8 : F.bid;
    const int gw = vb * NW + F.wave, NGW = F.G * NW, lane = lane_now();
    for (int m0 = gw * 8; m0 < M; m0 += NGW * 8) {
        const int b = m0 / SEQ;
        const float* mb = F.mod + (size_t)b * 6144;
        f32x4 mul[4], add[4];
#pragma unroll
        for (int j = 0; j < 4; ++j) {
            const int col = 4 * lane + 256 * j;
            mul[j] = *(const f32x4*)(g + col) * (*(const f32x4*)(mb + iscale * 1024 + col) + 1.f);
            add[j] = *(const f32x4*)(mb + ishift * 1024 + col);
        }
#pragma unroll 2
        for (int i = 0; i < 8; ++i) {
            const int m = m0 + i;
            const f32x4* xr = (const f32x4*)(X + (size_t)m * D) + lane;
            f32x4 v[4]; float s = 0.f;
#pragma unroll
            for (int j = 0; j < 4; ++j) { v[j] = __builtin_nontemporal_load(xr + 64 * j); s += (v[j].x * v[j].x + v[j].y * v[j].y) + (v[j].z * v[j].z + v[j].w * v[j].w); }
            const float rstd = rsqrtf(wave_sum(s) * (1.f / D) + EPS);
            unsigned long long* o8 = (unsigned long long*)(Hout + (size_t)m * D) + lane;
#pragma unroll
            for (int j = 0; j < 4; ++j) {
                const f32x4 h = v[j] * rstd * mul[j] + add[j];
                o8[64 * j] = (unsigned long long)pk2(h.x, h.y) | ((unsigned long long)pk2(h.z, h.w) << 32);
            }
        }
    }
}

template <bool DUAL, class Epi>
__device__ __forceinline__ void ngemm(Frame& F, const bf16_t* A, int lda, const bf16_t* Bt, int K, int N, const Epi& epi) {
    const long total = (long)(M / 4) * N;
    for (long idx = (long)F.bid * NT + tid_now(); idx < total; idx += (long)F.G * NT) {
        const int n = (int)(idx % N), m0 = (int)(idx / N) * 4;
        const int r0 = DUAL ? (n / 128) * 256 + (n % 128) : n;
        const v4u* b0 = (const v4u*)(Bt + (size_t)r0 * K);
        const v4u* b1 = (const v4u*)(Bt + (size_t)(r0 + 128) * K);
        const v4u* a0 = (const v4u*)(A + (size_t)m0 * lda);
        float acc0 = 0.f, acc1 = 0.f, acc2 = 0.f, acc3 = 0.f, bcc0 = 0.f, bcc1 = 0.f, bcc2 = 0.f, bcc3 = 0.f;
        for (int k8 = 0; k8 < K / 8; ++k8) {
            const v4u bv = b0[k8];
            const v4u av0 = a0[k8], av1 = a0[k8 + lda / 8], av2 = a0[k8 + 2 * (lda / 8)], av3 = a0[k8 + 3 * (lda / 8)];
            acc0 += dot8(av0, bv); acc1 += dot8(av1, bv); acc2 += dot8(av2, bv); acc3 += dot8(av3, bv);
            if (DUAL) { const v4u bw = b1[k8]; bcc0 += dot8(av0, bw); bcc1 += dot8(av1, bw); bcc2 += dot8(av2, bw); bcc3 += dot8(av3, bw); }
        }
        epi(m0, n, acc0, bcc0); epi(m0 + 1, n, acc1, bcc1); epi(m0 + 2, n, acc2, bcc2); epi(m0 + 3, n, acc3, bcc3);
    }
}
struct NEpiBf16 { bf16_t* O; int ldc; __device__ __forceinline__ void operator()(int m, int n, float a, float) const { O[(size_t)m * ldc + n] = (bf16_t)f2bf(a); } };
struct NEpiF32 { float* O; int ldc; __device__ __forceinline__ void operator()(int m, int n, float a, float) const { O[(size_t)m * ldc + n] = a; } };
struct NEpiRes { const float* base; float* out; const float* mod; int igate;
    __device__ __forceinline__ void operator()(int m, int n, float a, float) const { const int b = m / SEQ; out[(size_t)m * D + n] = base[(size_t)m * D + n] + mod[b * 6144 + igate * 1024 + n] * a; } };
struct NEpiSwiglu { bf16_t* O; __device__ __forceinline__ void operator()(int m, int n, float g, float u) const { O[(size_t)m * FF + n] = (bf16_t)f2bf(siluf(g) * u); } };

__device__ __forceinline__ void rope_freq_cs(int i, int pos, float& cs, float& sn) {
    const float freq = 1.0f / powf(10000.0f, (float)i * (1.0f / 32.0f));
    const float ang = (float)pos * freq;
    sincosf(ang, &sn, &cs);
}
__device__ __forceinline__ void p_qpost(Frame& F, const float* tmp) {
    const int gw = F.bid * NW + F.wave, NGW = F.G * NW, lane = lane_now();
    for (int m = gw; m < M; m += NGW) {
        const bf16_t* pr = F.PROJ + (size_t)m * NPROJ + C_CQ;
        float s = 0.f;
#pragma unroll
        for (int i = 0; i < 6; ++i) { const float v = bf2f(pr[lane + 64 * i]); s += v * v; }
        const float rstd_cq = rsqrtf(wave_sum(s) * (1.f / QRANK) + EPS);
        const int pos = F.pos[m];
        float cs, sn; rope_freq_cs(lane & 31, pos, cs, sn);
#pragma unroll
        for (int h = 0; h < 4; ++h) {
            float q[3]; float ss = 0.f;
#pragma unroll
            for (int i = 0; i < 3; ++i) { q[i] = tmp[(size_t)m * 1024 + h * 256 + lane + 64 * i] * rstd_cq; ss += q[i] * q[i]; }
            const float rstd = rsqrtf(wave_sum(ss) * (1.f / MQK) + EPS);
#pragma unroll
            for (int i = 0; i < 3; ++i) q[i] = q[i] * rstd * F.q_norm[lane + 64 * i];
            const float partner = __shfl_xor(q[2], 32);
            q[2] = (lane < 32) ? (q[2] * cs - partner * sn) : (q[2] * cs + partner * sn);
            const float qs = 0.10411754714f;
#pragma unroll
            for (int i = 0; i < 3; ++i) F.QM[((size_t)m * 4 + h) * MQK + lane + 64 * i] = (bf16_t)f2bf(q[i] * qs);
        }
    }
}
__device__ __forceinline__ void p_kvpost(Frame& F, const float* tmp) {
    const int gw = F.bid * NW + F.wave, NGW = F.G * NW, lane = lane_now();
    for (int m = gw; m < M; m += NGW) {
        const bf16_t* pr = F.PROJ + (size_t)m * NPROJ;
        float s = 0.f;
#pragma unroll
        for (int i = 0; i < 4; ++i) { const float v = bf2f(pr[C_CKV + lane + 64 * i]); s += v * v; }
        const float rstd_ckv = rsqrtf(wave_sum(s) * (1.f / KVRANK) + EPS);
        const int pos = F.pos[m];
        float cs, sn; rope_freq_cs(lane & 31, pos, cs, sn);
        float kr = bf2f(pr[C_KR + lane]);
        const float rstd_kr = rsqrtf(wave_sum(kr * kr) * (1.f / MROPE) + EPS);
        kr = kr * rstd_kr * F.k_rope_norm[lane];
        const float partner = __shfl_xor(kr, 32);
        kr = (lane < 32) ? (kr * cs - partner * sn) : (kr * cs + partner * sn);
#pragma unroll
        for (int h = 0; h < 4; ++h) {
            float k[2], v[2]; float ss = 0.f;
#pragma unroll
            for (int i = 0; i < 2; ++i) { k[i] = tmp[(size_t)m * 1024 + h * 256 + lane + 64 * i] * rstd_ckv; ss += k[i] * k[i]; v[i] = tmp[(size_t)m * 1024 + h * 256 + 128 + lane + 64 * i] * rstd_ckv; }
            const float rstd = rsqrtf(wave_sum(ss) * (1.f / MNOPE) + EPS);
#pragma unroll
            for (int i = 0; i < 2; ++i) {
                F.KM[((size_t)m * 4 + h) * MQK + lane + 64 * i] = (bf16_t)f2bf(k[i] * rstd * F.k_nope_norm[lane + 64 * i]);
                F.VM[((size_t)m * 4 + h) * MV + lane + 64 * i] = (bf16_t)f2bf(v[i]);
            }
            F.KM[((size_t)m * 4 + h) * MQK + 128 + lane] = (bf16_t)f2bf(kr);
        }
    }
}


__device__ __forceinline__ void p_rope_table(Frame& F, int first_block, int nblocks) {
    if (F.bid < first_block || nblocks <= 0) return;
    const int gt = (F.bid - first_block) * NT + tid_now(), NGT = nblocks * NT;
    for (int idx = gt; idx < M * 32; idx += NGT) { float cs, sn; rope_freq_cs(idx & 31, F.pos[idx >> 5], cs, sn); F.COS[idx] = cs; F.SIN[idx] = sn; }
}
__device__ __forceinline__ float ssq8(v4u a) {
    float s = 0.f;
    { const float lo = bf2f(a.x & 0xffffu), hi = __uint_as_float(a.x & 0xffff0000u); s += lo * lo + hi * hi; }
    { const float lo = bf2f(a.y & 0xffffu), hi = __uint_as_float(a.y & 0xffff0000u); s += lo * lo + hi * hi; }
    { const float lo = bf2f(a.z & 0xffffu), hi = __uint_as_float(a.z & 0xffff0000u); s += lo * lo + hi * hi; }
    { const float lo = bf2f(a.w & 0xffffu), hi = __uint_as_float(a.w & 0xffff0000u); s += lo * lo + hi * hi; }
    return s;
}
__device__ __forceinline__ void p3_stats(Frame& F, int pm, int pn) {
    LAS float* st = (LAS float*)(F.lds + pg8::ST_OFF);
    const int lane = lane_now(), l8 = lane & 7;
    f32x4 gk[2];
    gk[0] = *(const f32x4*)(F.k_rope_norm + 8 * l8); gk[1] = *(const f32x4*)(F.k_rope_norm + 8 * l8 + 4);
#pragma unroll 2
    for (int p = 0; p < 4; ++p) {
        const int r = F.wave * 32 + p * 8 + (lane >> 3); const size_t row = (size_t)pm * 256 + r;
        const bf16_t* pr = F.PROJ + row * NPROJ + C_CQ + l8 * 8;
        v4u v[11];
#pragma unroll
        for (int i = 0; i < 11; ++i) v[i] = *(const v4u*)(pr + 64 * i);
        const int i0 = (8 * l8) & 31;
        const f32x4 cs0 = *(const f32x4*)(F.COS + row * 32 + i0), cs1 = *(const f32x4*)(F.COS + row * 32 + i0 + 4);
        const f32x4 sn0 = *(const f32x4*)(F.SIN + row * 32 + i0), sn1 = *(const f32x4*)(F.SIN + row * 32 + i0 + 4);
        float s_cq = 0.f, s_ckv = 0.f;
#pragma unroll
        for (int i = 0; i < 6; ++i) s_cq += ssq8(v[i]);
#pragma unroll
        for (int i = 6; i < 10; ++i) s_ckv += ssq8(v[i]);
        float s_kr = ssq8(v[10]);
        s_cq += __shfl_xor(s_cq, 1); s_ckv += __shfl_xor(s_ckv, 1); s_kr += __shfl_xor(s_kr, 1);
        s_cq += __shfl_xor(s_cq, 2); s_ckv += __shfl_xor(s_ckv, 2); s_kr += __shfl_xor(s_kr, 2);
        s_cq += __shfl_xor(s_cq, 4); s_ckv += __shfl_xor(s_ckv, 4); s_kr += __shfl_xor(s_kr, 4);
        if (l8 == 0) { st[r] = rsqrtf(s_cq * (1.f / QRANK) + EPS); st[256 + r] = rsqrtf(s_ckv * (1.f / KVRANK) + EPS); }
        const float rk = rsqrtf(s_kr * (1.f / MROPE) + EPS);
        const v4u b = v[10];
        float x[8];
        x[0] = bf2f(b.x & 0xffffu) * rk * gk[0][0]; x[1] = __uint_as_float(b.x & 0xffff0000u) * rk * gk[0][1];
        x[2] = bf2f(b.y & 0xffffu) * rk * gk[0][2]; x[3] = __uint_as_float(b.y & 0xffff0000u) * rk * gk[0][3];
        x[4] = bf2f(b.z & 0xffffu) * rk * gk[1][0]; x[5] = __uint_as_float(b.z & 0xffff0000u) * rk * gk[1][1];
        x[6] = bf2f(b.w & 0xffffu) * rk * gk[1][2]; x[7] = __uint_as_float(b.w & 0xffff0000u) * rk * gk[1][3];
        float y[8];
#pragma unroll
        for (int e = 0; e < 8; ++e) { const float part = __shfl_xor(x[e], 4); const float cs = (e < 4) ? cs0[e & 3] : cs1[e & 3], sn = (e < 4) ? sn0[e & 3] : sn1[e & 3];
            y[e] = (l8 < 4) ? (x[e] * cs - part * sn) : (x[e] * cs + part * sn); }
        v4u w; w.x = pk2(y[0], y[1]); w.y = pk2(y[2], y[3]); w.z = pk2(y[4], y[5]); w.w = pk2(y[6], y[7]);
        *(v4u*)(F.KM + (row * 4 + pn) * MQK + MNOPE + 8 * l8) = w;
    }
}
__device__ __forceinline__ void p3_mla_up(Frame& F) {
    const int v = (F.G % 8 == 0) ? (F.bid % 8) * (F.G / 8) + F.bid / 8 : F.bid;
    if (v < 256) {
        const int pm = v >> 2, pn = v & 3;
        __syncthreads();
        p3_stats(F, pm, pn);
        __syncthreads();
        const pg8::OneUnit S{pm, pn};
        { pg8::Gemm g{F.PROJ + C_CQ, F.Wq_t, M, 1024, QRANK, NPROJ};
          pg8::gemm_phase<pg8::EpiQ, pg8::OneUnit, false>(F.lds, g, S, pg8::EpiQ{F.QM, F.q_norm, F.COS, F.SIN}); }
        { pg8::Gemm g{F.PROJ + C_CKV, F.Wkv_t, M, 1024, KVRANK, NPROJ};
          pg8::gemm_phase<pg8::EpiKV, pg8::OneUnit, false>(F.lds, g, S, pg8::EpiKV{F.KM, F.VM, F.k_nope_norm}); }
    }
}

__device__ __forceinline__ void p_attn_naive(Frame& F) {
    const int gw = F.bid * NW + F.wave, NGW = F.G * NW, lane = lane_now();
    for (int it = gw; it < BATCH * SBH * SEQ; it += NGW) {
        const int t = it % SEQ, h = (it / SEQ) % SBH, b = it / (SEQ * SBH);
        const size_t row = (size_t)b * SEQ + t;
        const float q = bf2f(F.PROJ[row * NPROJ + h * 64 + lane]);
        float accl = 0.f, o = 0.f;
        for (int s = t - 1; s >= 0; --s) {
            const bf16_t* kr = F.PROJ + ((size_t)b * SEQ + s) * NPROJ + h * 64 + lane;
            const float z = wave_sum(q * bf2f(kr[512])) * 0.6931471805599453f;
            const float lb = logsig(z);
            const float w = expf(lb + accl);
            o += w * bf2f(kr[1024]);
            accl += lb - z;
        }
        F.O[row * D + h * 64 + lane] = (bf16_t)f2bf(o);
        const float ss = wave_sum(o * o);
        if (lane == 0) F.SS[row * 16 + h] = ss;
    }
    for (int it = gw; it < BATCH * MH * SEQ; it += NGW) {
        const int t = it % SEQ, h = (it / SEQ) % MH, b = it / (SEQ * MH);
        const size_t row = (size_t)b * SEQ + t;
        float q[3];
#pragma unroll
        for (int i = 0; i < 3; ++i) q[i] = bf2f(F.QM[(row * 4 + h) * MQK + lane + 64 * i]);
        float mx = -INFINITY, l = 0.f, o0 = 0.f, o1 = 0.f;
        for (int s = 0; s <= t; ++s) {
            const size_t kr = ((size_t)b * SEQ + s) * 4 + h;
            float d = 0.f;
#pragma unroll
            for (int i = 0; i < 3; ++i) d += q[i] * bf2f(F.KM[kr * MQK + lane + 64 * i]);
            const float z = wave_sum(d);
            const float mn = fmaxf(mx, z), corr = exp2f(mx - mn), p = exp2f(z - mn);
            l = l * corr + p;
            o0 = o0 * corr + p * bf2f(F.VM[kr * MV + lane]);
            o1 = o1 * corr + p * bf2f(F.VM[kr * MV + 64 + lane]);
            mx = mn;
        }
        o0 /= l; o1 /= l;
        F.O[row * D + 512 + h * 128 + lane] = (bf16_t)f2bf(o0);
        F.O[row * D + 512 + h * 128 + 64 + lane] = (bf16_t)f2bf(o1);
        const float ss = wave_sum(o0 * o0 + o1 * o1);
        if (lane == 0) F.SS[row * 16 + 8 + h] = ss;
    }
}

__device__ __forceinline__ void p_attn_mla(Frame& F, unsigned* qctr) {
    LAS unsigned* slot = (LAS unsigned*)(F.lds + att::SLOT_OFF);
    if (F.G == 256) {
        const int x = F.bid & 7, idx = F.bid >> 3, bh = 4 * x + (idx >> 3), qb = 7 - (idx & 7);
        __syncthreads();
        att::mla_unit(F.lds, F.QM, F.KM, F.VM, F.O, F.SS, bh >> 2, bh & 3, qb);
        return;
    }
    for (;;) {
        __syncthreads();
        if (tid_now() == 0) *slot = atomicAdd(qctr, 1u);
        __syncthreads();
        const unsigned u = *slot;
        if (u >= 256u) break;
        const int r = (int)u & 31, qb = 7 - ((int)u >> 5);
        att::mla_unit(F.lds, F.QM, F.KM, F.VM, F.O, F.SS, r >> 2, r & 3, qb);
    }
}
__device__ __forceinline__ void p_attn_sb(Frame& F, unsigned* qctr) {
    LAS unsigned* slot = (LAS unsigned*)(F.lds + att::SLOT_OFF);
    const bool xl = (F.G == 256);
    const int x = F.bid & 7;
    unsigned* ctr = xl ? qctr + 64 * (1 + x) : qctr;
    const unsigned nunits = xl ? 64u : 512u;
    for (;;) {
        __syncthreads();
        if (tid_now() == 0) *slot = atomicAdd(ctr, 1u);
        __syncthreads();
        const unsigned u = *slot;
        if (u >= nunits) break;
        int bh, qb;
        if (xl) { bh = 8 * x + ((int)u & 7); qb = 7 - ((int)u >> 3); } else { bh = (int)u & 63; qb = 7 - ((int)u >> 6); }
        att::sb_unit(F.lds, F.PROJ, F.O, F.SS, bh >> 3, bh & 7, qb);
    }
}
__device__ __forceinline__ void p_mixnorm(Frame& F, bf16_t* Hout) {
    const int gw = F.bid * NW + F.wave, NGW = F.G * NW, lane = lane_now();
    for (int m = gw; m < M; m += NGW) {
        float s0 = 0.f, s1 = 0.f;
#pragma unroll
        for (int h = 0; h < 8; ++h) s0 += F.SS[(size_t)m * 16 + h];
#pragma unroll
        for (int h = 0; h < 4; ++h) s1 += F.SS[(size_t)m * 16 + 8 + h];
        const float r0 = rsqrtf(s0 * (1.f / 512) + EPS), r1 = rsqrtf(s1 * (1.f / 512) + EPS);
#pragma unroll
        for (int i = 0; i < 16; ++i) {
            const int col = lane + 64 * i;
            Hout[(size_t)m * D + col] = (bf16_t)f2bf(bf2f(F.O[(size_t)m * D + col]) * (col < 512 ? r0 : r1));
        }
    }
}


#define XB_TMO      128
#define XB_XCNT(j)  (256  + 64 * (j))
#define XB_XSUB(j)  (1280 + 64 * (j))
#define XB_XGEN(j)  (2304 + 64 * (j))
#define XB_TOP      3328
#define XB_TOPGEN   3392
#define XCD_BAR_WORDS 3456
#define XB_SPIN_CAP (1u << 18)
__device__ __forceinline__ unsigned xb_ld(unsigned* p)              { return __hip_atomic_load(p, __ATOMIC_RELAXED, __HIP_MEMORY_SCOPE_AGENT); }
__device__ __forceinline__ unsigned xb_add(unsigned* p, unsigned v) { return __hip_atomic_fetch_add(p, v, __ATOMIC_RELAXED, __HIP_MEMORY_SCOPE_AGENT); }
__device__ __forceinline__ unsigned xb_xcc_id() { return (unsigned)__builtin_amdgcn_s_getreg((3 << 11) | 20) & 0xFu; }
#define XB_SPIN(cond, bar) do { unsigned _sp = 0; while (cond) { __builtin_amdgcn_s_sleep(1); \
    if ((++_sp & 255u) == 0u) { if (xb_ld(&(bar)[XB_TMO])) break; if (_sp > XB_SPIN_CAP) { atomicAdd(&(bar)[XB_TMO], 1u); break; } } } } while (0)
struct XcdBarrier { unsigned* bar; unsigned x; volatile LAS unsigned* st; };
__device__ __forceinline__ XcdBarrier xcd_barrier_post(unsigned* bar, volatile LAS unsigned* st) {
    XcdBarrier b; b.bar = bar; b.x = xb_xcc_id(); b.st = st;
    if (threadIdx.x == 0) (void)xb_add(&bar[XB_XCNT(b.x)], 1u);
    return b;
}
__device__ __forceinline__ void xcd_barrier_complete(unsigned* bar, unsigned x, unsigned& nloc, unsigned& nx) {
    const unsigned G = gridDim.x * gridDim.y * gridDim.z;
    unsigned sum, cnt, mine, sp = 0u;
    for (;;) {
        sum = 0u; cnt = 0u; mine = 0u;
#pragma unroll
        for (unsigned j = 0; j < 16; ++j) { const unsigned c = xb_ld(&bar[XB_XCNT(j)]); sum += c; cnt += (c > 0u) ? 1u : 0u; mine = (j == x) ? c : mine; }
        if (sum == G) break;
        __builtin_amdgcn_s_sleep(1);
        if ((++sp & 255u) == 0u) { if (xb_ld(&bar[XB_TMO])) break; if (sp > XB_SPIN_CAP) { atomicAdd(&bar[XB_TMO], 1u); break; } }
    }
    nloc = mine > 0u ? mine : 1u; nx = cnt > 0u ? cnt : 1u;
}
__device__ __forceinline__ void xcd_barrier(const XcdBarrier& b) {
    asm volatile("s_waitcnt vmcnt(0)" ::: "memory");
    __syncthreads();
    if (threadIdx.x == 0) {
        unsigned* bar = b.bar;
        __builtin_amdgcn_s_waitcnt(0);
        unsigned nloc = b.st[0], nx = b.st[1];
        if (nloc == 0u) { xcd_barrier_complete(bar, b.x, nloc, nx); b.st[0] = nloc; b.st[1] = nx; }
        const unsigned old = xb_add(&bar[XB_XSUB(b.x)], 1u);
        const unsigned gen = old / nloc;
        if (old + 1u == (gen + 1u) * nloc) {
            __builtin_amdgcn_fence(__ATOMIC_RELEASE, "agent");
            asm volatile("s_waitcnt vmcnt(0)" ::: "memory");
            const unsigned og = xb_add(&bar[XB_TOP], 1u);
            const unsigned tg = og / nx;
            if (og + 1u == (tg + 1u) * nx) xb_add(&bar[XB_TOPGEN], 1u);
            else XB_SPIN(xb_ld(&bar[XB_TOPGEN]) == tg, bar);
            __builtin_amdgcn_fence(__ATOMIC_ACQUIRE, "agent");
            xb_add(&bar[XB_XGEN(b.x)], 1u);
            asm volatile("s_waitcnt vmcnt(0)" ::: "memory");
        } else {
            XB_SPIN(xb_ld(&bar[XB_XGEN(b.x)]) == gen, bar);
            __builtin_amdgcn_fence(__ATOMIC_ACQUIRE, "agent");
            asm volatile("s_waitcnt vmcnt(0)" ::: "memory");
        }
    }
    __syncthreads();
}

constexpr int NPHASE = 9;
__global__ void __launch_bounds__(NT, 2) mega(Args args) {
    extern __shared__ __attribute__((aligned(16))) unsigned char lds[];
    cg::grid_group grid = cg::this_grid();
    Frame F;
    F.lds = (LAS unsigned char*)lds;
    F.wave = __builtin_amdgcn_readfirstlane((int)threadIdx.x >> 6); F.G = gridDim.x; F.bid = blockIdx.x;
    F.x = args.in[0]; F.c = args.in[1]; F.pos = (const int*)args.in[2]; F.w_ada = args.in[3]; F.b_ada = args.in[4]; F.norm_attn = args.in[5]; F.norm_ffn = args.in[6];
    F.w_in = args.in[7]; F.q_a_norm = args.in[8]; F.w_q_up = args.in[9]; F.kv_a_norm = args.in[10]; F.w_kv_up = args.in[11]; F.q_norm = args.in[12];
    F.k_nope_norm = args.in[13]; F.k_rope_norm = args.in[14]; F.out_norm_sb = args.in[15]; F.out_norm_mla = args.in[16]; F.w_out = args.in[17];
    F.w_gate = args.in[18]; F.w_up = args.in[19]; F.w_down = args.in[20];
    F.out = args.out;
    unsigned char* ws = args.ws;
    F.mod = (float*)(ws + WS_MOD);
    F.Win_t = (bf16_t*)(ws + WS_WIN); F.Wq_t = (bf16_t*)(ws + WS_WQ); F.Wkv_t = (bf16_t*)(ws + WS_WKV); F.Wout_t = (bf16_t*)(ws + WS_WOUT);
    F.Wgu_t = (bf16_t*)(ws + WS_WGU); F.Wd_t = (bf16_t*)(ws + WS_WD);
    F.SS = (float*)(ws + WS_SS); F.H = (bf16_t*)(ws + WS_H); F.PROJ = (bf16_t*)(ws + WS_PROJ); F.QM = (bf16_t*)(ws + WS_QM); F.KM = (bf16_t*)(ws + WS_KM);
    F.VM = (bf16_t*)(ws + WS_VM); F.O = (bf16_t*)(ws + WS_O); F.A2 = (bf16_t*)(ws + WS_A2);
    F.COS = (float*)(ws + WS_COS); F.SIN = (float*)(ws + WS_SIN);

    const int lo = args.ph_lo, hi = args.ph_hi;
#define IN(k) (lo <= (k) && (k) < hi)
    volatile LAS unsigned* MISC = (volatile LAS unsigned*)(F.lds + MISC_OFF);
    if (tid_now() < 16) MISC[tid_now()] = 0u;
    __syncthreads();
    const XcdBarrier bar = xcd_barrier_post((unsigned*)(ws + WS_CTL), MISC + 8);
    if (lo < 0) grid.sync();
#define SEAM(k) do { if ((k) + 1 < hi) xcd_barrier(bar); } while (0)
    if (IN(0)) { p0_prep(F); SEAM(0); }
    if (IN(1)) { p_hnorm(F, F.x, F.norm_attn, 0, 1, F.H); SEAM(1); }
    if (IN(2)) { pg8::Gemm g{F.H, F.Win_t, M, NPROJ, D, D}; pg8::StaticOrder S; S.init(M, NPROJ, F.G, F.bid); pg8::gemm_phase<pg8::EpiBf16, pg8::StaticOrder, true>(F.lds, g, S, pg8::EpiBf16{F.PROJ, NPROJ}); p2_tail_ffn_weights(F); if (F.G > 64) p_rope_table(F, 64, F.G - 64); else p_rope_table(F, 0, F.G); SEAM(2); }
    if (IN(3)) { p3_mla_up(F); SEAM(3); }
    if (IN(4)) { unsigned* qc = (unsigned*)((unsigned char*)F.mod + WS_QC); p_attn_mla(F, qc); p_attn_sb(F, qc + 64); SEAM(4); }
    if (IN(5)) {
        pg8::Gemm g{F.O, F.Wout_t, M, D, D, D}; pg8::StaticOrder S; S.init(M, D, F.G, F.bid);
        pg8::Unit u0; u0.pm = 0; u0.pn = 0; (void)S.next(0, u0);
        LAS float* tw = (LAS float*)(F.lds + pg8::ST_OFF);
        { const int t = tid_now();
          if (t < 256) { const float* ss = F.SS + (size_t)(u0.pm * 256 + t) * 16;
              const f32x4 a = *(const f32x4*)ss, b = *(const f32x4*)(ss + 4), c = *(const f32x4*)(ss + 8);
              const float ssb = ((a[0] + a[1]) + (a[2] + a[3])) + ((b[0] + b[1]) + (b[2] + b[3])), smla = (c[0] + c[1]) + (c[2] + c[3]);
              tw[t] = sqrtf((smla * (1.f / 512) + EPS) / (ssb * (1.f / 512) + EPS)); tw[256 + t] = rsqrtf(smla * (1.f / 512) + EPS); } }
        __syncthreads();
        pg8::gemm_phase<pg8::EpiResNorm, pg8::StaticOrder, false>(F.lds, g, S, pg8::EpiResNorm{F.x, F.out, F.mod, tw, F.norm_ffn, F.H, (unsigned*)((unsigned char*)F.mod + WS_XBUF), (unsigned*)((unsigned char*)F.mod + WS_PCNT)});
        SEAM(5); }
    if (IN(7)) { pg8::Gemm g{F.H, F.Wgu_t, M, 2 * FF, D, D}; pg8::StaticOrder S; S.init(M, 2 * FF, F.G, F.bid); pg8::gemm_phase<pg8::EpiSwiglu, pg8::StaticOrder, true>(F.lds, g, S, pg8::EpiSwiglu{F.A2, FF}); SEAM(7); }
    if (IN(8)) { pg8::Gemm g{F.A2, F.Wd_t, M, D, FF, FF}; pg8::StaticOrder S; S.init(M, D, F.G, F.bid); pg8::gemm_phase<pg8::EpiRes, pg8::StaticOrder, true>(F.lds, g, S, pg8::EpiRes{F.out, F.out, F.mod + 5 * 1024}); }
#undef IN
#undef SEAM
}

extern "C" void kernel_launch(void* const* d_in, const int* in_sizes, int n_in, void* d_out, int out_size, void* d_ws, size_t ws_size, hipStream_t stream) {
    static int grid = 0;
    if (grid == 0) {
        if (n_in != 21 || out_size != M * D || ws_size < WS_END) { fprintf(stderr, "kernel_launch: unexpected shapes (n_in %d out %d ws %zu)\n", n_in, out_size, ws_size); grid = -1; return; }
        int dev = 0, cus = 0, per_cu = 0;
        hipGetDevice(&dev);
        hipDeviceGetAttribute(&cus, hipDeviceAttributeMultiprocessorCount, dev);
        if (hipFuncSetAttribute((const void*)mega, hipFuncAttributeMaxDynamicSharedMemorySize, LDS_BYTES) != hipSuccess) { fprintf(stderr, "kernel_launch: hipFuncSetAttribute failed\n"); grid = -1; return; }
        if (hipOccupancyMaxActiveBlocksPerMultiprocessor(&per_cu, (const void*)mega, NT, LDS_BYTES) != hipSuccess || per_cu < 1) { fprintf(stderr, "kernel_launch: occupancy query says %d\n", per_cu); per_cu = 1; }
        (void)hipGetLastError();
        if (cus < 256) { fprintf(stderr, "kernel_launch: needs >= 256 CUs (got %d)\n", cus); grid = -1; return; }
        grid = 256;
    }
    if (grid < 0) return;
    if (hipMemsetAsync((char*)d_ws + WS_CTL, 0, CTL_ZERO_BYTES, stream) != hipSuccess) { fprintf(stderr, "kernel_launch: hipMemsetAsync failed\n"); return; }
    Args a{};
    for (int i = 0; i < 21; ++i) a.in[i] = (const float*)d_in[i];
    a.out = (float*)d_out; a.ws = (unsigned char*)d_ws; a.ph_lo = 0; a.ph_hi = NPHASE;
    void* params[] = {&a};
    hipError_t e = hipLaunchCooperativeKernel((const void*)mega, dim3(grid), dim3(NT), params, LDS_BYTES, stream);
    if (e != hipSuccess) fprintf(stderr, "kernel_launch: cooperative launch failed: %s (grid %d)\n", hipGetErrorString(e), grid);
}
```
